# Optimizing an MI355X kernel written in HIP

```python
import math
import jax, jax.numpy as jnp
from jax import lax
import numpy as np

D_MODEL = 1024
BATCH = 8
SEQ = 4096
DEPTH = 1

HEAD_DIM = 64
FOX_HEADS = 8
SWA_HEADS = 8
SWA_KV_HEADS = 2
SWA_GROUP = SWA_HEADS // SWA_KV_HEADS
MIX_WIDTH = (FOX_HEADS + SWA_HEADS) * HEAD_DIM
WINDOW = 128
BLOCK = 128
N_BUCKETS = 32
MAX_DISTANCE = 128
N_EXPERTS = 32
TOP_K = 4
D_EXPERT = D_MODEL
SWIGLU_LIMIT = 7.0
SWIGLU_ALPHA = 1.702
EXPERT_BLOCK = 128
EPS = 1e-6
IN_SPLITS = (FOX_HEADS * HEAD_DIM, FOX_HEADS * HEAD_DIM, FOX_HEADS * HEAD_DIM, FOX_HEADS,
             SWA_HEADS * HEAD_DIM, SWA_KV_HEADS * HEAD_DIM, SWA_KV_HEADS * HEAD_DIM)
IN_WIDTH = sum(IN_SPLITS)

kernel_name = "hymba_fox_swa_sink_moe_layer"


def rms_norm(x, g):
    xf = x.astype(jnp.float32)
    y = xf * lax.rsqrt(jnp.mean(xf * xf, axis=-1, keepdims=True) + EPS)
    return (y * g.astype(jnp.float32)).astype(x.dtype)


def t5_bucket(n):
    max_exact = N_BUCKETS // 2
    nf = jnp.maximum(n, 1).astype(jnp.float32)
    large = max_exact + (jnp.log(nf / max_exact) / math.log(MAX_DISTANCE / max_exact)
                         * (N_BUCKETS - max_exact)).astype(jnp.int32)
    large = jnp.minimum(large, N_BUCKETS - 1)
    return jnp.where(n < max_exact, n, large)


def fox_attention(q, k, v, f_logit):
    b, s, h, dh = q.shape
    nb = s // BLOCK
    c = jnp.cumsum(jax.nn.log_sigmoid(f_logit.astype(jnp.float32)), axis=1).transpose(0, 2, 1)
    scale = dh ** -0.5
    kpos = jnp.arange(s)
    q_blocks = q.reshape(b, nb, BLOCK, h, dh).transpose(1, 0, 3, 2, 4)
    c_blocks = c.reshape(b, h, nb, BLOCK).transpose(2, 0, 1, 3)
    starts = jnp.arange(nb) * BLOCK

    def one_block(args):
        qb, cb, start = args
        logits = jnp.einsum('bhqd,bshd->bhqs', qb, k).astype(jnp.float32) * scale
        logits = logits + cb[..., None] - c[:, :, None, :]
        qpos = start + jnp.arange(BLOCK)
        causal = kpos[None, :] <= qpos[:, None]
        logits = jnp.where(causal, logits, -jnp.inf)
        p = jax.nn.softmax(logits, axis=-1).astype(v.dtype)
        return jnp.einsum('bhqs,bshd->bqhd', p, v)

    out = lax.map(one_block, (q_blocks, c_blocks, starts))
    return out.transpose(1, 0, 2, 3, 4).reshape(b, s, h * dh)


def swa_sink_attention(q, k, v, sinks, rel_bias):
    b, s, hq, dh = q.shape
    nb = s // BLOCK
    qb = q.reshape(b, nb, BLOCK, SWA_KV_HEADS, SWA_GROUP, dh)

    def band(t):
        tb = t.reshape(b, nb, BLOCK, SWA_KV_HEADS, dh)
        prev = jnp.pad(tb[:, :-1], ((0, 0), (1, 0), (0, 0), (0, 0), (0, 0)))
        return jnp.concatenate([prev, tb], axis=2)

    kw, vw = band(k), band(v)
    logits = jnp.einsum('bnqhgd,bnshd->bnhgqs', qb, kw).astype(jnp.float32) * dh ** -0.5
    qi = jnp.arange(BLOCK)[:, None]
    kj = jnp.arange(2 * BLOCK)[None, :]
    dist = qi + BLOCK - kj
    bias = rel_bias.astype(jnp.float32)[t5_bucket(jnp.maximum(dist, 0))]
    bias = bias.transpose(2, 0, 1).reshape(SWA_KV_HEADS, SWA_GROUP, BLOCK, 2 * BLOCK)
    key_pos = jnp.arange(nb)[:, None, None] * BLOCK - BLOCK + kj[None]
    valid = (dist >= 0) & (dist < WINDOW) & (key_pos >= 0)
    logits = jnp.where(valid[None, :, None, None], logits + bias, -jnp.inf)
    sink = jnp.broadcast_to(sinks.astype(jnp.float32).reshape(SWA_KV_HEADS, SWA_GROUP, 1, 1),
                            logits.shape[:-1] + (1,))
    probs = jax.nn.softmax(jnp.concatenate([logits, sink], axis=-1), axis=-1)[..., :-1].astype(v.dtype)
    out = jnp.einsum('bnhgqs,bnshd->bnqhgd', probs, vw)
    return out.reshape(b, s, hq * dh)


def moe_ffn(x, w_router, b_router, w_up_gate, b_up_gate, w_down, b_down):
    b, s, d = x.shape
    n = b * s
    xt = x.reshape(n, d)
    logits = (xt @ w_router).astype(jnp.float32) + b_router.astype(jnp.float32)
    top_val, top_idx = lax.top_k(logits, TOP_K)
    gates = jax.nn.softmax(top_val, axis=-1)
    n_assign = n * TOP_K
    e_flat = top_idx.reshape(-1).astype(jnp.int32)
    tok_flat = jnp.arange(n_assign, dtype=jnp.int32) // TOP_K
    g_flat = gates.reshape(-1)
    order = jnp.argsort(e_flat)
    e_sorted = e_flat[order]
    counts = jnp.zeros((N_EXPERTS,), jnp.int32).at[e_flat].add(1)
    padded = (counts + EXPERT_BLOCK - 1) // EXPERT_BLOCK * EXPERT_BLOCK
    start = jnp.cumsum(counts) - counts
    pstart = jnp.cumsum(padded) - padded
    pend = pstart + padded
    dest = pstart[e_sorted] + jnp.arange(n_assign, dtype=jnp.int32) - start[e_sorted]
    rows = n_assign + N_EXPERTS * EXPERT_BLOCK
    row_tok = jnp.full((rows,), n, jnp.int32).at[dest].set(tok_flat[order])
    row_gate = jnp.zeros((rows,), jnp.float32).at[dest].set(g_flat[order])
    nblk = rows // EXPERT_BLOCK
    blk_start = jnp.arange(nblk, dtype=jnp.int32) * EXPERT_BLOCK
    blk_exp = jnp.minimum(jnp.sum(pend[None, :] <= blk_start[:, None], axis=1), N_EXPERTS - 1)
    x_pad = jnp.concatenate([xt, jnp.zeros((1, d), xt.dtype)], axis=0)
    x_rows = x_pad[row_tok].reshape(nblk, EXPERT_BLOCK, d)

    def expert_block(args):
        xb, e = args
        gu = xb @ w_up_gate[e] + b_up_gate[e]
        gate = jnp.minimum(gu[:, :D_EXPERT], SWIGLU_LIMIT)
        up = jnp.clip(gu[:, D_EXPERT:], -SWIGLU_LIMIT, SWIGLU_LIMIT)
        act = (up + 1) * (gate * jax.nn.sigmoid(SWIGLU_ALPHA * gate))
        return act @ w_down[e] + b_down[e]

    y_rows = lax.map(expert_block, (x_rows, blk_exp)).reshape(rows, d)
    y = jax.ops.segment_sum(y_rows * row_gate[:, None].astype(y_rows.dtype), row_tok,
                            num_segments=n + 1)[:n]
    return y.reshape(b, s, d)


def setup_inputs(seed: int = 0) -> dict:
    key = jax.random.key(seed)
    ks = jax.random.split(key, 20)
    f32 = jnp.float32
    nrm = lambda k, shape, scale: jax.random.normal(k, shape, f32) * scale
    return {
        "x": nrm(ks[0], (BATCH, SEQ, D_MODEL), 1.0),
        "norm_mix": 1.0 + nrm(ks[1], (DEPTH, D_MODEL), 0.02),
        "w_in": nrm(ks[2], (DEPTH, D_MODEL, IN_WIDTH), D_MODEL ** -0.5),
        "b_forget": 2.0 + nrm(ks[3], (DEPTH, FOX_HEADS), 0.5),
        "q_norm_fox": 1.0 + nrm(ks[4], (DEPTH, HEAD_DIM), 0.02),
        "k_norm_fox": 1.0 + nrm(ks[5], (DEPTH, HEAD_DIM), 0.02),
        "q_norm_swa": 1.0 + nrm(ks[6], (DEPTH, HEAD_DIM), 0.02),
        "k_norm_swa": 1.0 + nrm(ks[7], (DEPTH, HEAD_DIM), 0.02),
        "sinks": nrm(ks[8], (DEPTH, SWA_HEADS), 0.5),
        "rel_bias": nrm(ks[9], (N_BUCKETS, SWA_HEADS), 0.5),
        "w_out": nrm(ks[10], (DEPTH, MIX_WIDTH, D_MODEL), MIX_WIDTH ** -0.5),
        "norm_moe": 1.0 + nrm(ks[11], (DEPTH, D_MODEL), 0.02),
        "w_router": nrm(ks[12], (DEPTH, D_MODEL, N_EXPERTS), D_MODEL ** -0.5),
        "b_router": nrm(ks[13], (DEPTH, N_EXPERTS), 0.01),
        "w_up_gate": nrm(ks[14], (DEPTH, N_EXPERTS, D_MODEL, 2 * D_EXPERT), D_MODEL ** -0.5),
        "b_up_gate": nrm(ks[15], (DEPTH, N_EXPERTS, 2 * D_EXPERT), 0.02),
        "w_down": nrm(ks[16], (DEPTH, N_EXPERTS, D_EXPERT, D_MODEL), D_EXPERT ** -0.5),
        "b_down": nrm(ks[17], (DEPTH, N_EXPERTS, D_MODEL), 0.02),
    }


def reference(x, norm_mix, w_in, b_forget, q_norm_fox, k_norm_fox, q_norm_swa, k_norm_swa,
              sinks, rel_bias, w_out, norm_moe, w_router, b_router, w_up_gate, b_up_gate,
              w_down, b_down):
    b, s, _ = x.shape
    points = [int(p) for p in np.cumsum(IN_SPLITS)[:-1]]
    h = x
    for l in range(DEPTH):
        hn = rms_norm(h, norm_mix[l])
        proj = hn @ w_in[l]
        qa, ka, va, fa, qb, kb, vb = jnp.split(proj, points, axis=-1)
        qa = rms_norm(qa.reshape(b, s, FOX_HEADS, HEAD_DIM), q_norm_fox[l])
        ka = rms_norm(ka.reshape(b, s, FOX_HEADS, HEAD_DIM), k_norm_fox[l])
        va = va.reshape(b, s, FOX_HEADS, HEAD_DIM)
        out_a = fox_attention(qa, ka, va, fa + b_forget[l])
        qb = rms_norm(qb.reshape(b, s, SWA_HEADS, HEAD_DIM), q_norm_swa[l])
        kb = rms_norm(kb.reshape(b, s, SWA_KV_HEADS, HEAD_DIM), k_norm_swa[l])
        vb = vb.reshape(b, s, SWA_KV_HEADS, HEAD_DIM)
        out_b = swa_sink_attention(qb, kb, vb, sinks[l], rel_bias)
        h = h + jnp.concatenate([out_a, out_b], axis=-1) @ w_out[l]
        h = h + moe_ffn(rms_norm(h, norm_moe[l]), w_router[l], b_router[l], w_up_gate[l],
                        b_up_gate[l], w_down[l], b_down[l])
    return h
```

```cpp
#include <hip/hip_runtime.h>
#include <hip/hip_bf16.h>
#include <cstdio>
#include <cstdint>

#define LAS __attribute__((address_space(3)))
#define GAS __attribute__((address_space(1)))
typedef unsigned short bf16_t;
typedef short bf16x8 __attribute__((ext_vector_type(8)));
typedef short s16x4 __attribute__((ext_vector_type(4)));
typedef float f32x4 __attribute__((ext_vector_type(4)));
typedef float f32x2 __attribute__((ext_vector_type(2)));
typedef float f32x16 __attribute__((ext_vector_type(16)));
typedef unsigned u32x4 __attribute__((ext_vector_type(4)));
typedef unsigned u32x2 __attribute__((ext_vector_type(2)));
typedef __bf16 bf16x2_t __attribute__((ext_vector_type(2)));

constexpr int DM = 1024, NB = 8, SEQ = 4096, NTOK = NB * SEQ;
constexpr int HD = 64, FH = 8, SH = 8, SKV = 2;
constexpr int INW = 2312, NPROJ = 2304;
constexpr int QKVP = NPROJ;
constexpr int COL_FQ = 0, COL_FK = 512, COL_FV = 1024, COL_SQ = 1536, COL_SK = 2048, COL_SV = 2176;
constexpr int NE = 32, TOPK = 4, DE = 1024;
constexpr int ECAP = 32768;
constexpr int MOE_ROWS = NTOK * TOPK + NE * 256;
constexpr float EPS = 1e-6f;
constexpr float LOG2E = 1.4426950408889634f;
constexpr float C2 = 0.125f * LOG2E;

__device__ __forceinline__ unsigned cvtpk(float lo, float hi) { f32x2 v = {lo, hi}; bf16x2_t b = __builtin_convertvector(v, bf16x2_t); return __builtin_bit_cast(unsigned, b); }
__device__ __forceinline__ unsigned pk4_fp8(float a, float b, float c, float d) { int r = 0; r = __builtin_amdgcn_cvt_pk_fp8_f32(a, b, r, false); r = __builtin_amdgcn_cvt_pk_fp8_f32(c, d, r, true); return (unsigned)r; }
__device__ __forceinline__ float clamp448(float v) { return __builtin_amdgcn_fmed3f(v, -448.f, 448.f); }
__device__ __forceinline__ float bf2f(unsigned short h) { return __builtin_bit_cast(float, (unsigned)h << 16); }

namespace pg8 {
constexpr int BM = 256, BK = 64, HALF = 128, HTB = HALF * BK * 2, STAGE_BYTES = 8 * HTB, NXCD = 8, WGM = 8;
__host__ __device__ __forceinline__ int lds_byte(int r, int c) { const int st = (r >> 4) * 2 + (c >> 5), rr = r & 15, cc = c & 31, ob = rr * 64 + cc * 2; return st * 1024 + (ob ^ (((ob >> 9) & 1) << 5)); }
__host__ __device__ __forceinline__ void stage_rc(int b, int& R, int& C) { const int st = b / 1024, sb = b % 1024, swz = sb ^ (((sb >> 9) & 1) << 5); R = (st >> 1) * 16 + swz / 64; C = (st & 1) * 32 + (swz % 64) / 2; }
__host__ __device__ __forceinline__ int perm32(int rho) { const int n = rho >> 4, i = rho & 15; return 8 * (i >> 2) + 4 * n + (i & 3); }

struct Tile { int pm, pn; };
typedef int v8i32 __attribute__((ext_vector_type(8)));
typedef int v4i32 __attribute__((ext_vector_type(4)));
__device__ __forceinline__ v8i32 cat8(bf16x8 a, bf16x8 b) { return __builtin_shufflevector(__builtin_bit_cast(v4i32, a), __builtin_bit_cast(v4i32, b), 0, 1, 2, 3, 4, 5, 6, 7); }
__device__ __forceinline__ bool static_tile(int i, int G, int c, int nM, int nN, Tile& u) {
    const int nwg = nM * nN; const long L = (long)i * G + c; if (L >= nwg) return false;
    int wgid = (int)L; { const int q = nwg / NXCD, r = nwg % NXCD, xcd = wgid % NXCD, off = wgid / NXCD; wgid = (xcd < r ? xcd * (q + 1) : r * (q + 1) + (xcd - r) * q) + off; }
    const int nig = WGM * nN, gid = wgid / nig, fm = gid * WGM, gsz = (nM - fm) < WGM ? (nM - fm) : WGM;
    u.pm = fm + ((wgid % nig) % gsz); u.pn = (wgid % nig) / gsz; return true;
}
template <int BMODE> __host__ __device__ __forceinline__ int brow(int R) { return BMODE == 0 ? R : BMODE == 1 ? ((R & ~31) + perm32(R & 31)) : BMODE == 2 ? (64 * (R >> 5) + perm32(R & 31)) : (64 * (R >> 5) + 16 * ((R >> 2) & 3) + 4 * ((R >> 4) & 1) + (R & 3)); }

template <int BMODE, bool FP8, class Prob>
__device__ __forceinline__ void gemm_phase(LAS unsigned char* lds, const char* Abase, const int KB, const Prob& S) {
    typedef typename Prob::Unit Unit;
    const int tid = threadIdx.x, wid = __builtin_amdgcn_readfirstlane(tid >> 6), lane = tid & 63, wr = wid >> 2, wc = wid & 3, fr = lane & 15, fq = lane >> 4;
    const int nt = KB / 128;
    int Rl[2], Cl[2]; unsigned voffB[2];
#pragma unroll
    for (int i = 0; i < 2; ++i) { int R, C; stage_rc(tid * 16 + i * 8192, R, C); Rl[i] = R; Cl[i] = C; voffB[i] = (unsigned)(brow<BMODE>(R) * KB + C * 2); }
    const size_t kstep = (size_t)(BK * 2);
    const size_t hstepB = (size_t)(BMODE == 2 ? 32 : BMODE == 3 ? 8 : HALF) * KB;
    const unsigned ldsw = (unsigned)wid * 1024u;
    const int aoff = lds_byte(wr * 64 + fr, fq * 8), boff = lds_byte(wc * 32 + fr, fq * 8);
#define PG8_SA(b, h) (((b) * 2 + (h)) * HTB)
#define PG8_SB(b, h) ((4 + (b) * 2 + (h)) * HTB)
#define PG8_STAGE(bufoff, gbase, voff) do { const char* gb_ = (const char*)(gbase); asm volatile("" : "+s"(gb_));   \
        _Pragma("unroll") for (int _i = 0; _i < 2; ++_i) \
        __builtin_amdgcn_global_load_lds((const unsigned*)(gb_ + (voff)[_i]), (LAS unsigned*)(lds + (bufoff) + ldsw + _i * 8192), 16, 0, 0); } while (0)
#define PG8_LDA(dst, b, h) do { _Pragma("unroll") for (int m = 0; m < 4; ++m) _Pragma("unroll") for (int k = 0; k < 2; ++k) dst[m][k] = *(const LAS bf16x8*)(lds + PG8_SA(b, h) + aoff + m * 2048 + k * 1024); } while (0)
#define PG8_LDB(dst, b, h) do { _Pragma("unroll") for (int n = 0; n < 2; ++n) _Pragma("unroll") for (int k = 0; k < 2; ++k) dst[n][k] = *(const LAS bf16x8*)(lds + PG8_SB(b, h) + boff + n * 2048 + k * 1024); } while (0)
#define PG8_MMA(ai, bj, At, Bt) do { __builtin_amdgcn_s_setprio(1); if constexpr (FP8) { _Pragma("unroll") for (int m = 0; m < 4; ++m) _Pragma("unroll") for (int n = 0; n < 2; ++n) { \
            const v8i32 fa = cat8(At[m][0], At[m][1]), fb = cat8(Bt[n][0], Bt[n][1]); \
            asm volatile("v_mfma_f32_16x16x128_f8f6f4 %0, %1, %2, %0" : "+v"(acc[ai][bj][m][n]) : "v"(fb), "v"(fa)); } } \
        else { _Pragma("unroll") for (int m = 0; m < 4; ++m) _Pragma("unroll") for (int n = 0; n < 2; ++n) _Pragma("unroll") for (int k = 0; k < 2; ++k) \
            acc[ai][bj][m][n] = __builtin_amdgcn_mfma_f32_16x16x32_bf16(Bt[n][k], At[m][k], acc[ai][bj][m][n], 0, 0, 0); } __builtin_amdgcn_s_setprio(0); } while (0)
#define PG8_WAIT_V(n) asm volatile("s_waitcnt vmcnt(" #n ")" ::: "memory")
#define PG8_WAIT_L(n) asm volatile("s_waitcnt lgkmcnt(" #n ")" ::: "memory")
#define PG8_BAR __builtin_amdgcn_s_barrier()
#define PG8_SCHED __builtin_amdgcn_sched_barrier(0)
    Unit cur, nxt; int ui = 0;
    if (!S.next(0, cur)) return;
    f32x4 acc[2][2][4][2];
#pragma unroll
    for (int a = 0; a < 2; ++a)
#pragma unroll
        for (int b = 0; b < 2; ++b)
#pragma unroll
            for (int m = 0; m < 4; ++m)
#pragma unroll
                for (int n = 0; n < 2; ++n) acc[a][b][m][n] = (f32x4){0.f, 0.f, 0.f, 0.f};
    bf16x8 At[4][2], B0[2][2], B1[2][2];
    constexpr bool GA = Prob::GATHER;
    unsigned oC[2][2], o2[2][2], voffA[2];
    const char* cA = Abase; const char* nA = Abase;
    const size_t hstepA = (size_t)HALF * KB;
    int tkN[2][2];
    if constexpr (GA) { S.aidx(cur, Rl, tkN); S.acalc(tkN, Cl, oC); }
    else {
#pragma unroll
        for (int i = 0; i < 2; ++i) voffA[i] = (unsigned)(Rl[i] * KB + Cl[i] * 2);
        cA = Abase + (size_t)S.arow(cur) * KB; }
#define PG8_STAGE_A(bufoff, pg, kb, h, og) do { if constexpr (GA) { PG8_STAGE(bufoff, Abase + (kb), og[h]); } else { PG8_STAGE(bufoff, (pg) + (kb) + (h) * hstepA, voffA); } } while (0)
    const char* cB = S.bbase(cur);
    PG8_STAGE(PG8_SB(0, 0), cB, voffB); PG8_STAGE(PG8_SB(0, 1), cB + hstepB, voffB); PG8_STAGE_A(PG8_SA(0, 0), cA, 0, 0, oC); PG8_STAGE_A(PG8_SA(0, 1), cA, 0, 1, oC);
    if (wr == 1) PG8_BAR;
    PG8_WAIT_V(2); PG8_BAR;
    PG8_STAGE(PG8_SB(1, 0), cB + kstep, voffB); PG8_STAGE_A(PG8_SA(1, 0), cA, kstep, 0, oC); PG8_STAGE(PG8_SB(1, 1), cB + hstepB + kstep, voffB);
    PG8_WAIT_V(6); PG8_BAR;
    for (;;) {
        const bool has_next = S.next(ui + 1, nxt);
        const char* nB = cB; nA = cA;
        if (has_next) { nB = S.bbase(nxt); if constexpr (!GA) nA = Abase + (size_t)S.arow(nxt) * KB; }
#pragma unroll 1
        for (int t = 0; t < nt; t += 2) {
            const bool last = (t == nt - 2);
            const size_t k1 = (size_t)(t + 1) * kstep, k2 = last ? 0 : (size_t)(t + 2) * kstep, k3 = k2 + kstep;
            const char* p2 = last ? nA : cA; const char* b2 = last ? nB : cB + (size_t)(t + 2) * kstep; const char* b3 = b2 + kstep;
            if constexpr (GA) {
                if (t == nt - 4 && has_next) { int Rr[2], Cc[2]; int t2 = tid; asm volatile("" : "+v"(t2)); stage_rc(t2 * 16, Rr[0], Cc[0]); stage_rc(t2 * 16 + 8192, Rr[1], Cc[1]); S.aidx(nxt, Rr, tkN); }
#pragma unroll
                for (int h = 0; h < 2; ++h)
#pragma unroll
                    for (int i = 0; i < 2; ++i) o2[h][i] = oC[h][i];
                if (last) {
                    if (has_next) { int Rr[2], Cc[2]; int t2 = tid; asm volatile("" : "+v"(t2)); stage_rc(t2 * 16, Rr[0], Cc[0]); stage_rc(t2 * 16 + 8192, Rr[1], Cc[1]); S.acalc(tkN, Cc, o2); }
                    asm volatile("" : "+v"(o2[0][0]), "+v"(o2[0][1]), "+v"(o2[1][0]), "+v"(o2[1][1]));
                } }
            asm volatile("" : "+v"(voffB[0]), "+v"(voffB[1]));
            if constexpr (GA) asm volatile("" : "+v"(oC[0][0]), "+v"(oC[0][1]), "+v"(oC[1][0]), "+v"(oC[1][1]), "+v"(o2[0][0]), "+v"(o2[0][1]), "+v"(o2[1][0]), "+v"(o2[1][1]));
            else asm volatile("" : "+v"(voffA[0]), "+v"(voffA[1]));
            PG8_LDB(B0, 0, 0); PG8_LDB(B1, 0, 1); PG8_SCHED; PG8_LDA(At, 0, 0); PG8_STAGE_A(PG8_SA(1, 1), cA, k1, 1, oC);
            PG8_WAIT_V(8); PG8_WAIT_L(0); PG8_BAR; PG8_MMA(0, 0, At, B0); PG8_MMA(0, 1, At, B1); PG8_BAR; PG8_SCHED;
            PG8_LDA(At, 0, 1); PG8_STAGE(PG8_SB(0, 0), b2, voffB); PG8_STAGE(PG8_SB(0, 1), b2 + hstepB, voffB); PG8_STAGE_A(PG8_SA(0, 0), p2, k2, 0, o2);
            PG8_WAIT_V(8); PG8_WAIT_L(0); PG8_BAR; PG8_MMA(1, 0, At, B0); PG8_MMA(1, 1, At, B1); PG8_BAR; PG8_SCHED;
            PG8_LDB(B0, 1, 0); PG8_LDB(B1, 1, 1); PG8_SCHED; PG8_LDA(At, 1, 0); PG8_STAGE_A(PG8_SA(0, 1), p2, k2, 1, o2);
            PG8_WAIT_V(8); PG8_WAIT_L(0); PG8_BAR; PG8_MMA(0, 0, At, B0); PG8_MMA(0, 1, At, B1); PG8_BAR; PG8_SCHED;
            PG8_LDA(At, 1, 1); PG8_STAGE(PG8_SB(1, 0), b3, voffB); PG8_STAGE(PG8_SB(1, 1), b3 + hstepB, voffB); PG8_STAGE_A(PG8_SA(1, 0), p2, k3, 0, o2);
            PG8_WAIT_V(8); PG8_WAIT_L(0); PG8_BAR; PG8_MMA(1, 0, At, B0); PG8_MMA(1, 1, At, B1); PG8_BAR; PG8_SCHED;
        }
        if (wr == 0) PG8_BAR;
        if constexpr (FP8) asm volatile("s_nop 15\n\ts_nop 15" ::: "memory");
        S.epi(acc, cur, wr, wc, fr, fq);
        if (!has_next) break;
#pragma unroll
        for (int a = 0; a < 2; ++a)
#pragma unroll
            for (int b = 0; b < 2; ++b)
#pragma unroll
                for (int m = 0; m < 4; ++m)
#pragma unroll
                    for (int n = 0; n < 2; ++n) acc[a][b][m][n] = (f32x4){0.f, 0.f, 0.f, 0.f};
        cur = nxt; cB = nB; cA = nA; ++ui;
        if constexpr (GA) {
#pragma unroll
            for (int h = 0; h < 2; ++h)
#pragma unroll
                for (int i = 0; i < 2; ++i) oC[h][i] = o2[h][i]; }
        if (wr == 1) PG8_BAR;
    }
    PG8_WAIT_V(0);
    PG8_BAR;
#undef PG8_SA
#undef PG8_SB
#undef PG8_STAGE
#undef PG8_STAGE_A
#undef PG8_LDA
#undef PG8_LDB
#undef PG8_MMA
#undef PG8_WAIT_V
#undef PG8_WAIT_L
#undef PG8_BAR
#undef PG8_SCHED
}
}

namespace att {
typedef LAS const char* lds_cptr;
typedef short v4i16_t __attribute__((ext_vector_type(4)));
constexpr int NSLOT = 3, SLOTB = 8192;
constexpr int LDS_K = 0, LDS_V = NSLOT * SLOTB, LDS_WS = 2 * NSLOT * SLOTB, LDS_OST = LDS_WS + 8 * 256, LDS_TB = LDS_OST + 8 * 4096, LDS_KX = LDS_TB + 8 * 256 * 4, LDS_END = LDS_KX + NSLOT * 1024;
constexpr float THR = 20.f;
#define SBAR() __builtin_amdgcn_sched_barrier(0)
__device__ __forceinline__ int crow(int r, int hi) { return (r & 3) + 8 * (r >> 2) + 4 * hi; }
__device__ __forceinline__ void glds16(const void* gsrc, unsigned lds_dst) { unsigned keep;
    asm volatile("s_mov_b32 %0, m0\n\ts_mov_b32 m0, %2\n\ts_nop 0\n\tglobal_load_lds_dwordx4 %1, off\n\ts_mov_b32 m0, %0" : "=&s"(keep) : "v"(gsrc), "s"(lds_dst) : "memory"); }
#define MFMA32(a, b, c) __builtin_amdgcn_mfma_f32_32x32x16_bf16(a, b, c, 0, 0, 0)
__device__ __forceinline__ void k_load(bf16x8 (&kf)[8], lds_cptr kb) {
#pragma unroll
    for (int d0 = 0; d0 < 4; ++d0) { kf[2 * d0] = *(const LAS bf16x8*)(kb + d0 * 2048); kf[2 * d0 + 1] = *(const LAS bf16x8*)(kb + d0 * 2048 + 512); }
}
__device__ __forceinline__ void qkt(f32x16& p0, f32x16& p1, const bf16x8 (&kf)[8], const bf16x8* qr, const f32x16& negm) {
    p0 = MFMA32(kf[0], qr[0], negm); p1 = MFMA32(kf[1], qr[0], negm);
#pragma unroll
    for (int d0 = 1; d0 < 4; ++d0) { p0 = MFMA32(kf[2 * d0], qr[d0], p0); p1 = MFMA32(kf[2 * d0 + 1], qr[d0], p1); }
}
__device__ __forceinline__ float rowmax(const f32x16& p0, const f32x16& p1) {
    float a = __builtin_fmaxf(p0[0], p1[0]);
#pragma unroll
    for (int r = 1; r < 16; ++r) a = __builtin_fmaxf(__builtin_fmaxf(a, p0[r]), p1[r]);
    auto rr = __builtin_amdgcn_permlane32_swap(__float_as_uint(a), __float_as_uint(a), false, false);
    return __builtin_fmaxf(__uint_as_float(rr[0]), __uint_as_float(rr[1]));
}
__device__ __forceinline__ s16x4 vtr(lds_cptr p) { return __builtin_bit_cast(s16x4, __builtin_amdgcn_ds_read_tr16_b64_v4i16((LAS v4i16_t*)p)); }
__device__ __forceinline__ void v_load(s16x4 (&lo)[8], s16x4 (&hi)[8], lds_cptr vp) {
#pragma unroll
    for (int i = 0; i < 8; ++i) { lo[i] = vtr(vp + ((i >> 2) * 4096 + (i & 3) * 1024)); hi[i] = vtr(vp + ((i >> 2) * 4096 + (i & 3) * 1024 + 512)); }
}
__device__ __forceinline__ void pv_mma(f32x16* o, const s16x4 (&lo)[8], const s16x4 (&hi)[8], bf16x8 pa0, bf16x8 pa1, bf16x8 pa2, bf16x8 pa3) {
#define VFR(i) (bf16x8){lo[i][0], lo[i][1], lo[i][2], lo[i][3], hi[i][0], hi[i][1], hi[i][2], hi[i][3]}
    o[0] = MFMA32(pa0, VFR(0), o[0]); o[1] = MFMA32(pa0, VFR(4), o[1]);
    o[0] = MFMA32(pa1, VFR(1), o[0]); o[1] = MFMA32(pa1, VFR(5), o[1]);
    o[0] = MFMA32(pa2, VFR(2), o[0]); o[1] = MFMA32(pa2, VFR(6), o[1]);
    o[0] = MFMA32(pa3, VFR(3), o[0]); o[1] = MFMA32(pa3, VFR(7), o[1]);
#undef VFR
    const bf16x8 ones = __builtin_bit_cast(bf16x8, (u32x4){0x3F803F80u, 0x3F803F80u, 0x3F803F80u, 0x3F803F80u});
    o[2] = MFMA32(pa0, ones, o[2]); o[2] = MFMA32(pa1, ones, o[2]); o[2] = MFMA32(pa2, ones, o[2]); o[2] = MFMA32(pa3, ones, o[2]);
}

struct UnitArgs {
    const bf16_t* Qw;
    const bf16_t* Kh;
    const bf16_t* Vh;
    const bf16_t* kx;
    bf16_t* Ow;
    int nt;
    bool nomax;
    int t_first;
    int qw_rel;
    int tb_off;
    float sink2;
};
template <bool FOX> __device__ __forceinline__ void attn_unit(const UnitArgs& A, LAS char* shm) {
    const int tid = threadIdx.x, lane = tid & 63, r32 = lane & 31, hi = lane >> 5; const int wid = __builtin_amdgcn_readfirstlane(tid >> 6);
    const unsigned lds0 = (unsigned)(uintptr_t)shm;
    LAS float* wsf = (LAS float*)(shm + LDS_WS) + wid * 64;
    const bf16_t* ksrc = A.Kh + (long)lane * QKVP + wid * 8;
    const bf16_t* vsrc = A.Vh + (long)(16 * (wid & 3) + (lane >> 2)) * QKVP + (wid >> 2) * 32 + (lane & 3) * 8;
    const unsigned kdst = lds0 + LDS_K + wid * 1024, vdst = lds0 + LDS_V + wid * 1024, xdst = lds0 + LDS_KX;
    const bf16_t* xsrc = A.kx + (long)lane * 8;
#define DMA_K(t, slot) glds16(ksrc + (long)(t) * 64 * QKVP, (unsigned)__builtin_amdgcn_readfirstlane(kdst + (slot)))
#define DMA_V(t, slot) glds16(vsrc + (long)(t) * 64 * QKVP, (unsigned)__builtin_amdgcn_readfirstlane(vdst + (slot)))
#define DMA_X(t, slot) glds16(xsrc + (long)(t) * 64 * 8, (unsigned)__builtin_amdgcn_readfirstlane(xdst + ((slot) >> 3)))
    const lds_cptr vp0 = (lds_cptr)shm + LDS_V + ((lane >> 4) & 1) * 32 + (lane & 3) * 8 + (4 * hi + ((lane & 15) >> 2)) * 64;
    const lds_cptr kp0 = (lds_cptr)shm + LDS_K + hi * 1024 + r32 * 16;
    const int nt = A.nt;
    DMA_K(0, 0); DMA_V(0, 0); if (FOX) DMA_X(0, 0);
    bf16x8 qr[4];
#pragma unroll
    for (int d0 = 0; d0 < 4; ++d0) qr[d0] = *(const GAS bf16x8*)(A.Qw + (long)r32 * QKVP + d0 * 16 + hi * 8);
    const u32x4 one3 = {0x3F803F80u, 0x00003F80u, 0u, 0u}, zero4 = {0u, 0u, 0u, 0u};
    const bf16x8 qx0 = __builtin_bit_cast(bf16x8, hi == 0 ? one3 : zero4), qx1 = __builtin_bit_cast(bf16x8, hi == 1 ? one3 : zero4);
    float m_ref = 0.f; f32x16 o[3]; o[0] = f32x16{}; o[1] = f32x16{}; o[2] = f32x16{}; f32x16 negm = f32x16{};
    if (FOX) { m_ref = -A.sink2;
#pragma unroll
        for (int r = 0; r < 16; ++r) negm[r] = A.sink2; }
    const int qrel = A.qw_rel + r32;
    int sl_cur = 0, sl_next = SLOTB;
    asm volatile("s_waitcnt vmcnt(0)" : "+v"(qr[0]), "+v"(qr[1]), "+v"(qr[2]), "+v"(qr[3]) :: "memory");
    for (int t = 0; t < nt; ++t) {
        if (t + 1 < nt) {
            DMA_K(t + 1, sl_next); DMA_V(t + 1, sl_next);
            if (FOX) { DMA_X(t + 1, sl_next); asm volatile("s_waitcnt vmcnt(3) lgkmcnt(0)\n\ts_barrier" ::: "memory"); }
            else asm volatile("s_waitcnt vmcnt(2) lgkmcnt(0)\n\ts_barrier" ::: "memory");
        } else asm volatile("s_waitcnt vmcnt(0) lgkmcnt(0)\n\ts_barrier" ::: "memory");
        const int kv0 = t * 64;
        const bool active = FOX ? (t >= A.t_first && kv0 <= A.qw_rel + 31) : true;
        if (active) {
            f32x16 p0, p1;
            bf16x8 kf[8]; s16x4 vlo[8], vhi[8];
            k_load(kf, kp0 + sl_cur);
            v_load(vlo, vhi, vp0 + sl_cur);
            SBAR();
            __builtin_amdgcn_s_setprio(1);
            qkt(p0, p1, kf, qr, negm);
            if (FOX) {
                const bf16x8 kxf = *(const LAS bf16x8*)(shm + LDS_KX + (sl_cur >> 3) + lane * 16);
                p0 = MFMA32(kxf, qx0, p0); p1 = MFMA32(kxf, qx1, p1);
                if (kv0 + 63 > A.qw_rel) {
#pragma unroll
                    for (int r = 0; r < 16; ++r) { const int kv = kv0 + crow(r, hi); if (kv > qrel) p0[r] = -INFINITY; if (kv + 32 > qrel) p1[r] = -INFINITY; }
                }
            } else {
                const LAS float* tb = (const LAS float*)(shm + A.tb_off);
#pragma unroll
                for (int r = 0; r < 16; ++r) { const int ix = qrel - (kv0 + crow(r, hi)) + 64; p0[r] += tb[ix]; p1[r] += tb[ix - 32]; }
            }
            __builtin_amdgcn_s_setprio(0);
            const bool need_max = !A.nomax || (FOX && kv0 + 63 > A.qw_rel);
            const float rm = need_max ? rowmax(p0, p1) : 0.f;
            if (need_max && __any(rm > THR)) {
                const float dl = __builtin_fmaxf(rm, 0.f); m_ref += dl; const float al = __builtin_amdgcn_exp2f(-dl);
#pragma unroll
                for (int r = 0; r < 16; ++r) { p0[r] -= dl; p1[r] -= dl; negm[r] = -m_ref; }
                if (hi == 0) wsf[r32] = al;
                asm volatile("s_waitcnt lgkmcnt(0)" ::: "memory");
#pragma unroll
                for (int j = 0; j < 4; ++j) { const f32x4 f = *(const LAS f32x4*)(wsf + 8 * j + 4 * hi);
#pragma unroll
                    for (int i = 0; i < 4; ++i) { o[0][4 * j + i] *= f[i]; o[1][4 * j + i] *= f[i]; o[2][4 * j + i] *= f[i]; } }
            }
#pragma unroll
            for (int r = 0; r < 16; ++r) { p0[r] = __builtin_amdgcn_exp2f(p0[r]); p1[r] = __builtin_amdgcn_exp2f(p1[r]); }
            const u32x4 pw0 = {cvtpk(p0[0], p0[1]), cvtpk(p0[2], p0[3]), cvtpk(p0[4], p0[5]), cvtpk(p0[6], p0[7])};
            const u32x4 pw1 = {cvtpk(p0[8], p0[9]), cvtpk(p0[10], p0[11]), cvtpk(p0[12], p0[13]), cvtpk(p0[14], p0[15])};
            const u32x4 pw2 = {cvtpk(p1[0], p1[1]), cvtpk(p1[2], p1[3]), cvtpk(p1[4], p1[5]), cvtpk(p1[6], p1[7])};
            const u32x4 pw3 = {cvtpk(p1[8], p1[9]), cvtpk(p1[10], p1[11]), cvtpk(p1[12], p1[13]), cvtpk(p1[14], p1[15])};
            SBAR();
            __builtin_amdgcn_s_setprio(1);
            pv_mma(o, vlo, vhi, __builtin_bit_cast(bf16x8, pw0), __builtin_bit_cast(bf16x8, pw1), __builtin_bit_cast(bf16x8, pw2), __builtin_bit_cast(bf16x8, pw3));
            __builtin_amdgcn_s_setprio(0);
        }
        sl_cur = sl_next; sl_next = (sl_next == (NSLOT - 1) * SLOTB) ? 0 : sl_next + SLOTB;
    }
    float rli[16];
    if (!FOX) {
        if (hi == 0) wsf[32 + r32] = __builtin_amdgcn_exp2f(A.sink2 - m_ref);
        asm volatile("s_waitcnt lgkmcnt(0)" ::: "memory");
#pragma unroll
        for (int r = 0; r < 16; ++r) rli[r] = __builtin_amdgcn_rcpf(o[2][r] + wsf[32 + crow(r, hi)]);
    } else {
#pragma unroll
        for (int r = 0; r < 16; ++r) rli[r] = __builtin_amdgcn_rcpf(o[2][r]);
    }
    { LAS bf16_t* stg = (LAS bf16_t*)(shm + LDS_OST) + wid * 2048;
#pragma unroll
      for (int r = 0; r < 16; ++r) { const int orow = crow(r, hi);
#pragma unroll
          for (int d0 = 0; d0 < 2; ++d0) stg[orow * 64 + d0 * 32 + r32] = (bf16_t)(cvtpk(o[d0][r] * rli[r], 0.f) & 0xffffu); }
      asm volatile("s_waitcnt lgkmcnt(0)" ::: "memory");
#pragma unroll
      for (int i = 0; i < 4; ++i) { const int row = i * 8 + (lane >> 3), ch = lane & 7; const u32x4 v = *(const LAS u32x4*)(stg + row * 64 + ch * 8); *(GAS u32x4*)(A.Ow + (long)row * DM + ch * 8) = v; } }
    asm volatile("s_waitcnt vmcnt(0) lgkmcnt(0)\n\ts_barrier" ::: "memory");
#undef DMA_K
#undef DMA_V
#undef DMA_X
}
#undef SBAR
}

constexpr size_t MiB = 1u << 20;
constexpr size_t WS_CTL = 0, CTL_ZERO_BYTES = 64 * 1024;
constexpr size_t WS_WIN = 2 * MiB;
constexpr size_t WS_WO = 7 * MiB;
constexpr size_t WS_KX = 9 * MiB;
constexpr size_t WS_C2F = 13 * MiB;
constexpr size_t WS_LOGF = 14 * MiB;
constexpr size_t WS_TOKL = 16 * MiB;
constexpr size_t WS_GATEL = 20 * MiB;
constexpr size_t WS_SLOT = 24 * MiB;
constexpr size_t WS_WUG = 32 * MiB;
constexpr size_t WS_WD = 160 * MiB;
constexpr size_t WS_HN = 224 * MiB;
constexpr size_t WS_QKV = 288 * MiB;
constexpr size_t WS_AO = 432 * MiB;
constexpr size_t WS_ACT = 288 * MiB;
constexpr size_t WS_Y = 560 * MiB;
constexpr size_t WS_PROJ = 704 * MiB;
constexpr size_t WS_END = 832 * MiB;
static_assert(WS_ACT + (size_t)MOE_ROWS * DE <= WS_Y && WS_Y + (size_t)MOE_ROWS * DM <= WS_PROJ && WS_PROJ + (size_t)NTOK * DM * 2 <= WS_END, "ws map");
constexpr int CW_TMO = 0, CW_QUEUE = 64, CW_CNT = 1024  , CW_BAR = 4096;

constexpr int RING_BYTES = 131072;
constexpr int AUX_OFF = RING_BYTES;
constexpr int TOKS_OFF = AUX_OFF + 16384;
constexpr int MISC_OFF = TOKS_OFF + 4096;
constexpr int LDS_BYTES = MISC_OFF + 1024;
constexpr int NWAVES = 8;

#define XB_TMO      128
#define XB_XCNT(j)  (256  + 64 * (j))
#define XB_XSUB(j)  (1280 + 64 * (j))
#define XB_XGEN(j)  (2304 + 64 * (j))
#define XB_TOP      3328
#define XB_TOPGEN   3392
#define XCD_BAR_WORDS 3456
#define XB_SPIN_CAP (1u << 18)
__device__ __forceinline__ unsigned xb_ld(unsigned* p)              { return __hip_atomic_load(p, __ATOMIC_RELAXED, __HIP_MEMORY_SCOPE_AGENT); }
__device__ __forceinline__ unsigned xb_add(unsigned* p, unsigned v) { return __hip_atomic_fetch_add(p, v, __ATOMIC_RELAXED, __HIP_MEMORY_SCOPE_AGENT); }
__device__ __forceinline__ unsigned xb_xcc_id() { return (unsigned)__builtin_amdgcn_s_getreg((3 << 11) | 20) & 0xFu; }
#define XB_SPIN(cond, bar) do { unsigned _sp = 0; while (cond) { __builtin_amdgcn_s_sleep(1); \
    if ((++_sp & 255u) == 0u) { if (xb_ld(&(bar)[XB_TMO])) break; if (_sp > XB_SPIN_CAP) { atomicAdd(&(bar)[XB_TMO], 1u); break; } } } } while (0)
struct XcdBarrier { unsigned* bar; unsigned x; volatile LAS unsigned* st; };
__device__ __forceinline__ XcdBarrier xcd_barrier_post(unsigned* bar, volatile LAS unsigned* st) {
    XcdBarrier b; b.bar = bar; b.x = xb_xcc_id(); b.st = st;
    if (threadIdx.x == 0) (void)xb_add(&bar[XB_XCNT(b.x)], 1u);
    return b;
}
__device__ __forceinline__ void xcd_barrier_complete(unsigned* bar, unsigned x, unsigned& nloc, unsigned& nx) {
    const unsigned G = gridDim.x * gridDim.y * gridDim.z;
    unsigned sum, cnt, mine, sp = 0u;
    for (;;) {
        sum = 0u; cnt = 0u; mine = 0u;
#pragma unroll
        for (unsigned j = 0; j < 16; ++j) { const unsigned c = xb_ld(&bar[XB_XCNT(j)]); sum += c; cnt += (c > 0u) ? 1u : 0u; mine = (j == x) ? c : mine; }
        if (sum == G) break;
        __builtin_amdgcn_s_sleep(1);
        if ((++sp & 255u) == 0u) { if (xb_ld(&bar[XB_TMO])) break; if (sp > XB_SPIN_CAP) { atomicAdd(&bar[XB_TMO], 1u); break; } }
    }
    nloc = mine > 0u ? mine : 1u; nx = cnt > 0u ? cnt : 1u;
}
__device__ __forceinline__ void xcd_barrier(const XcdBarrier& b) {
    asm volatile("s_waitcnt vmcnt(0)" ::: "memory");
    __syncthreads();
    if (threadIdx.x == 0) {
        unsigned* bar = b.bar;
        __builtin_amdgcn_s_waitcnt(0);
        unsigned nloc = b.st[0], nx = b.st[1];
        if (nloc == 0u) { xcd_barrier_complete(bar, b.x, nloc, nx); b.st[0] = nloc; b.st[1] = nx; }
        const unsigned old = xb_add(&bar[XB_XSUB(b.x)], 1u);
        const unsigned gen = old / nloc;
        if (old + 1u == (gen + 1u) * nloc) {
            __builtin_amdgcn_fence(__ATOMIC_RELEASE, "agent");
            asm volatile("s_waitcnt vmcnt(0)" ::: "memory");
            const unsigned og = xb_add(&bar[XB_TOP], 1u);
            const unsigned tg = og / nx;
            if (og + 1u == (tg + 1u) * nx) xb_add(&bar[XB_TOPGEN], 1u);
            else XB_SPIN(xb_ld(&bar[XB_TOPGEN]) == tg, bar);
            __builtin_amdgcn_fence(__ATOMIC_ACQUIRE, "agent");
            xb_add(&bar[XB_XGEN(b.x)], 1u);
            asm volatile("s_waitcnt vmcnt(0)" ::: "memory");
        } else {
            XB_SPIN(xb_ld(&bar[XB_XGEN(b.x)]) == gen, bar);
            __builtin_amdgcn_fence(__ATOMIC_ACQUIRE, "agent");
            asm volatile("s_waitcnt vmcnt(0)" ::: "memory");
        }
    }
    __syncthreads();
}

struct Args {
    const float* x; const float* norm_mix; const float* w_in; const float* b_forget; const float* qnf; const float* knf; const float* qns; const float* kns;
    const float* sinks; const float* rel_bias; const float* w_out; const float* norm_moe; const float* w_router; const float* b_router; const float* w_ug; const float* b_ug;
    const float* w_down; const float* b_down; float* out; unsigned char* ws; int ph_lo, ph_hi, li, pad;
};

__device__ __forceinline__ float wave_sum(float v) {
#define WS_DPP(x, ctrl) __builtin_bit_cast(float, __builtin_amdgcn_update_dpp(0, __builtin_bit_cast(int, (x)), (ctrl), 0xF, 0xF, false))
    v += WS_DPP(v, 0xB1); v += WS_DPP(v, 0x4E); v += WS_DPP(v, 0x141); v += WS_DPP(v, 0x140);
#undef WS_DPP
    { const auto r_ = __builtin_amdgcn_permlane16_swap(__float_as_uint(v), __float_as_uint(v), false, false); v = __uint_as_float(r_[0]) + __uint_as_float(r_[1]); }
    { const auto r_ = __builtin_amdgcn_permlane32_swap(__float_as_uint(v), __float_as_uint(v), false, false); v = __uint_as_float(r_[0]) + __uint_as_float(r_[1]); }
    return v;
}
#define LDS_WAIT() asm volatile("s_waitcnt lgkmcnt(0)" ::: "memory")

__device__ __forceinline__ void transpose_item(const float* W, int K, int ldw, int k0, int src_col0, bf16_t* WT, int dst_row0, LAS float* scr, int lane) {
#pragma unroll 8
    for (int i = 0; i < 32; ++i) { const int kk = 2 * i + (lane >> 5); scr[kk * 33 + (lane & 31)] = W[(size_t)(k0 + kk) * ldw + src_col0 + (lane & 31)]; }
    LDS_WAIT(); asm volatile("" ::: "memory");
    const int c = lane & 7;
#pragma unroll
    for (int j = 0; j < 4; ++j) { const int n = (lane >> 3) + 8 * j; const LAS float* s = scr + (8 * c) * 33 + n;
        u32x4 o; o.x = cvtpk(s[0 * 33], s[1 * 33]); o.y = cvtpk(s[2 * 33], s[3 * 33]); o.z = cvtpk(s[4 * 33], s[5 * 33]); o.w = cvtpk(s[6 * 33], s[7 * 33]);
        *(GAS u32x4*)(WT + (size_t)(dst_row0 + n) * K + k0 + 8 * c) = o; }
    LDS_WAIT(); asm volatile("" ::: "memory");
}

__device__ __forceinline__ void transpose_item_fp8(const float* W, int K, int ldw, int k0, int src_col0, unsigned char* WT, int dst_row0, float scale, LAS float* scr, int lane) {
#pragma unroll 8
    for (int i = 0; i < 32; ++i) { const int kk = 2 * i + (lane >> 5); scr[kk * 33 + (lane & 31)] = W[(size_t)(k0 + kk) * ldw + src_col0 + (lane & 31)] * scale; }
    LDS_WAIT(); asm volatile("" ::: "memory");
    const int c = lane & 7;
#pragma unroll
    for (int j = 0; j < 4; ++j) { const int n = (lane >> 3) + 8 * j; const LAS float* s = scr + (8 * c) * 33 + n;
        u32x2 o; o.x = pk4_fp8(s[0 * 33], s[1 * 33], s[2 * 33], s[3 * 33]); o.y = pk4_fp8(s[4 * 33], s[5 * 33], s[6 * 33], s[7 * 33]);
        *(GAS u32x2*)(WT + (size_t)(dst_row0 + n) * K + k0 + 8 * c) = o; }
    LDS_WAIT(); asm volatile("" ::: "memory");
}

constexpr int CV_UG_ITEMS = NE * 8 * 64, CV_D_ITEMS = NE * 8 * 32, CV_ITEMS = CV_UG_ITEMS + CV_D_ITEMS, CV_PER_UNIT = 24, CV_UNITS = CV_ITEMS / CV_PER_UNIT;
static_assert(CV_ITEMS % CV_PER_UNIT == 0, "conversion items per unit");
struct CvItem { const float* src; unsigned char* dst; int ldw; };
__device__ __forceinline__ CvItem cv_item(int it, const float* w_ug, const float* w_down, unsigned char* WugT, unsigned char* WdT) {
    CvItem c;
    if (it < CV_UG_ITEMS) { const int e = it >> 9, q = it & 511, kb = q >> 6, nb = q & 63, n0 = nb * 32;
        const int pn = n0 >> 8, bj = (n0 >> 7) & 1, rho = n0 & 127;
        c.src = w_ug + (size_t)e * DM * 2048 + (size_t)(kb * 128) * 2048 + bj * 1024 + pn * 128 + rho; c.dst = WugT + ((size_t)e * 2048 + n0) * DM + kb * 128; c.ldw = 2048; }
    else { const int r = it - CV_UG_ITEMS, e = r >> 8, q = r & 255, kb = q >> 5, nb = q & 31;
        c.src = w_down + (size_t)e * DE * DM + (size_t)(kb * 128) * DM + nb * 32; c.dst = WdT + ((size_t)e * DM + nb * 32) * DE + kb * 128; c.ldw = DM; }
    return c;
}
__device__ __forceinline__ void cv_load(f32x4 (&v)[16], const CvItem& c, int lane) {
    const GAS float* p = (const GAS float*)c.src + (size_t)(lane >> 3) * c.ldw + 4 * (lane & 7);
#pragma unroll
    for (int i = 0; i < 16; ++i) v[i] = *(const GAS f32x4*)(p + (size_t)(8 * i) * c.ldw);
}
__device__ __forceinline__ void cv_store(const f32x4 (&v)[16], const CvItem& c, LAS float* scr, int lane) {
    const int lk = lane >> 3, ln = lane & 7, n = lane & 31, kh = lane >> 5;
#pragma unroll
    for (int sub = 0; sub < 4; ++sub) {
#pragma unroll
        for (int i = 0; i < 4; ++i) *(LAS f32x4*)(scr + (8 * i + lk) * 36 + 4 * ln) = v[4 * sub + i] * 256.f;
        LDS_WAIT(); asm volatile("" ::: "memory");
        float t[16];
#pragma unroll
        for (int kk = 0; kk < 16; ++kk) t[kk] = clamp448(scr[(16 * kh + kk) * 36 + n]);
        LDS_WAIT(); asm volatile("" ::: "memory");
        const u32x4 o = {pk4_fp8(t[0], t[1], t[2], t[3]), pk4_fp8(t[4], t[5], t[6], t[7]), pk4_fp8(t[8], t[9], t[10], t[11]), pk4_fp8(t[12], t[13], t[14], t[15])};
        *(GAS u32x4*)(c.dst + (size_t)n * 1024 + 32 * sub + 16 * kh) = o;
    }
}
__device__ __forceinline__ void cv_unit(int unit, const float* w_ug, const float* w_down, unsigned char* WugT, unsigned char* WdT, LAS float* scr, int wave, int lane) {
    const int it0 = unit * CV_PER_UNIT + wave * 3;
    const CvItem c0 = cv_item(it0, w_ug, w_down, WugT, WdT), c1 = cv_item(it0 + 1, w_ug, w_down, WugT, WdT), c2 = cv_item(it0 + 2, w_ug, w_down, WugT, WdT);
    f32x4 va[16], vb[16];
    cv_load(va, c0, lane); cv_load(vb, c1, lane);
    cv_store(va, c0, scr, lane);
    cv_load(va, c2, lane);
    cv_store(vb, c1, scr, lane);
    cv_store(va, c2, scr, lane);
}

struct ProbIn {
    typedef pg8::Tile Unit;
    int G, c; const bf16_t* WT; bf16_t* QKV; const float *gqf, *gkf, *gqs, *gks;
    __device__ __forceinline__ bool next(int i, Unit& u) const { return pg8::static_tile(i, G, c, NTOK / 256, NPROJ / 256, u); }
    static constexpr bool GATHER = false;
    __device__ __forceinline__ int arow(const Unit& u) const { return u.pm * 256; }
    __device__ __forceinline__ void aidx(const Unit&, const int (&)[2], int (&)[2][2]) const {}
    __device__ __forceinline__ void acalc(const int (&)[2][2], const int (&)[2], unsigned (&)[2][2]) const {}
    __device__ __forceinline__ const char* bbase(const Unit& u) const { return (const char*)WT + (size_t)u.pn * 256 * DM * 2; }
    __device__ __forceinline__ void epi(const f32x4 (&acc)[2][2][4][2], const Unit& u, int wr, int wc, int fr, int fq) const {
        const int pn = u.pn; const float* g = nullptr; float sc = 1.f;
        if (pn < 2) { g = gqf; sc = C2; } else if (pn < 4) { g = gkf; } else if (pn < 6) { g = nullptr; } else if (pn < 8) { g = gqs; sc = C2; } else { g = (wc < 2) ? gks : nullptr; }
        f32x4 gv[2][2];
#pragma unroll
        for (int bj = 0; bj < 2; ++bj)
#pragma unroll
            for (int n = 0; n < 2; ++n) { const f32x4 gl = *(const f32x4*)((g ? g : gqf) + 32 * bj + 8 * fq + 4 * n); gv[bj][n] = g ? gl * sc : (f32x4){1.f, 1.f, 1.f, 1.f}; }
#pragma unroll
        for (int ai = 0; ai < 2; ++ai)
#pragma unroll
            for (int m = 0; m < 4; ++m) {
                float rs = 1.f;
                if (g) { float ss = 0.f;
#pragma unroll
                    for (int bj = 0; bj < 2; ++bj)
#pragma unroll
                        for (int n = 0; n < 2; ++n) { const f32x4 v = acc[ai][bj][m][n]; ss += (v[0] * v[0] + v[1] * v[1]) + (v[2] * v[2] + v[3] * v[3]); }
                    { const auto r_ = __builtin_amdgcn_permlane16_swap(__float_as_uint(ss), __float_as_uint(ss), false, false); ss = __uint_as_float(r_[0]) + __uint_as_float(r_[1]); }
                    { const auto r_ = __builtin_amdgcn_permlane32_swap(__float_as_uint(ss), __float_as_uint(ss), false, false); ss = __uint_as_float(r_[0]) + __uint_as_float(r_[1]); }
                    rs = __builtin_amdgcn_rsqf(ss * (1.f / 64.f) + EPS); }
                const int row = u.pm * 256 + ai * 128 + wr * 64 + m * 16 + fr;
                bf16_t* rowp = QKV + (size_t)row * QKVP + pn * 256 + wc * 64 + 8 * fq;
#pragma unroll
                for (int bj = 0; bj < 2; ++bj) { const f32x4 v0 = acc[ai][bj][m][0] * rs * gv[bj][0], v1 = acc[ai][bj][m][1] * rs * gv[bj][1];
                    u32x4 w; w.x = cvtpk(v0[0], v0[1]); w.y = cvtpk(v0[2], v0[3]); w.z = cvtpk(v1[0], v1[1]); w.w = cvtpk(v1[2], v1[3]);
                    *(GAS u32x4*)(rowp + 32 * bj) = w; } }
    }
};
struct ProbOut {
    typedef pg8::Tile Unit;
    int G, c; const bf16_t* WT; bf16_t* PROJ;
    __device__ __forceinline__ bool next(int i, Unit& u) const { return pg8::static_tile(i, G, c, NTOK / 256, DM / 256, u); }
    static constexpr bool GATHER = false;
    __device__ __forceinline__ int arow(const Unit& u) const { return u.pm * 256; }
    __device__ __forceinline__ void aidx(const Unit&, const int (&)[2], int (&)[2][2]) const {}
    __device__ __forceinline__ void acalc(const int (&)[2][2], const int (&)[2], unsigned (&)[2][2]) const {}
    __device__ __forceinline__ const char* bbase(const Unit& u) const { return (const char*)WT + (size_t)u.pn * 256 * DM * 2; }
    __device__ __forceinline__ void epi(const f32x4 (&acc)[2][2][4][2], const Unit& u, int wr, int wc, int fr, int fq) const {
        GAS bf16_t* pp = (GAS bf16_t*)PROJ + ((size_t)u.pm * 256 + wr * 64 + fr) * DM + u.pn * 256 + wc * 32 + 8 * fq;
#pragma unroll
        for (int ai = 0; ai < 2; ++ai) {
#pragma unroll
            for (int m = 0; m < 4; ++m) {
#pragma unroll
                for (int bj = 0; bj < 2; ++bj) { const f32x4 v0 = acc[ai][bj][m][0], v1 = acc[ai][bj][m][1];
                    *(GAS u32x4*)(pp + bj * 128) = (u32x4){cvtpk(v0[0], v0[1]), cvtpk(v0[2], v0[3]), cvtpk(v1[0], v1[1]), cvtpk(v1[2], v1[3])}; }
                pp += 16 * DM;
                asm volatile("" : "+v"(pp) :: "memory"); }
            pp += 64 * DM; }
    }
};
struct MoeUnit { int pm, pn, e, mt; };
struct MoeSched {
    int G, c, TT, nN; const LAS int* tstart;
    __device__ __forceinline__ bool next(int i, MoeUnit& u) const {
        pg8::Tile t; if (!pg8::static_tile(i, G, c, TT, nN, t)) return false;
        const int ln = threadIdx.x & 63;
        const int ts = tstart[ln & 31];
        const int e = (int)__builtin_popcountll(__ballot(ln >= 1 && ln < NE && ts <= t.pm));
        u.pm = t.pm; u.pn = t.pn; u.e = e; u.mt = t.pm - tstart[e]; return true; }
};
struct ProbUp {
    typedef MoeUnit Unit;
    MoeSched S; const unsigned char* WT; const int* tokl; const LAS int* cnt; const float* bug; unsigned char* ACT;
    static constexpr bool GATHER = true;
    __device__ __forceinline__ int arow(const Unit&) const { return 0; }
    __device__ __forceinline__ bool next(int i, Unit& u) const { return S.next(i, u); }
    __device__ __forceinline__ void aidx(const Unit& u, const int (&R)[2], int (&tk)[2][2]) const {
        const int n = cnt[u.e]; const GAS int* tl = (const GAS int*)tokl + (size_t)u.e * ECAP + u.mt * 256; const int rmax = n - 1 - u.mt * 256;
#pragma unroll
        for (int h = 0; h < 2; ++h)
#pragma unroll
            for (int i = 0; i < 2; ++i) { int r = h * 128 + R[i]; r = r < rmax ? r : rmax; tk[h][i] = tl[r]; } }
    __device__ __forceinline__ void acalc(const int (&tk)[2][2], const int (&C)[2], unsigned (&o)[2][2]) const {
#pragma unroll
        for (int h = 0; h < 2; ++h)
#pragma unroll
            for (int i = 0; i < 2; ++i) o[h][i] = (unsigned)(tk[h][i] * DM + C[i] * 2); }
    __device__ __forceinline__ const char* bbase(const Unit& u) const { return (const char*)WT + ((size_t)u.e * 2048 + (size_t)u.pn * 256) * DM; }
    __device__ __forceinline__ void epi(const f32x4 (&acc)[2][2][4][2], const Unit& u, int wr, int wc, int fr, int fq) const {
        const int cl = u.pn * 128 + wc * 32 + 8 * fq;
        const float* bg = bug + (size_t)u.e * 2048 + cl;
        const f32x4 bg0 = *(const f32x4*)bg, bg1 = *(const f32x4*)(bg + 4), bu0 = *(const f32x4*)(bg + 1024), bu1 = *(const f32x4*)(bg + 1028);
        typedef _Float16 h2 __attribute__((ext_vector_type(2))); typedef short s2v __attribute__((ext_vector_type(2)));
        h2 bgh[2][2], buh[2][2];
#pragma unroll
        for (int n = 0; n < 2; ++n)
#pragma unroll
            for (int hh = 0; hh < 2; ++hh) { const f32x4 a = n ? bg1 : bg0, b = n ? bu1 : bu0; bgh[n][hh] = __builtin_convertvector((f32x2){a[2 * hh], a[2 * hh + 1]}, h2); buh[n][hh] = __builtin_convertvector((f32x2){b[2 * hh] + 1.f, b[2 * hh + 1] + 1.f}, h2); }
        const h2 k256 = {(_Float16)0.00390625f, (_Float16)0.00390625f}, seven = {(_Float16)7.f, (_Float16)7.f}, msix = {(_Float16)-6.f, (_Float16)-6.f}, eight = {(_Float16)8.f, (_Float16)8.f}, one = {(_Float16)1.f, (_Float16)1.f};
        const h2 cexp = {(_Float16)(-1.702f * LOG2E), (_Float16)(-1.702f * LOG2E)};
        GAS unsigned char* ap = (GAS unsigned char*)ACT + ((size_t)u.pm * 256 + wr * 64 + fr) * DE + cl;
#pragma unroll
        for (int ai = 0; ai < 2; ++ai) {
#pragma unroll
            for (int m = 0; m < 4; ++m) { unsigned w[2];
#pragma unroll
                for (int n = 0; n < 2; ++n) { s2v pk = {0, 0};
#pragma unroll
                    for (int hh = 0; hh < 2; ++hh) {
                        h2 g = __builtin_convertvector((f32x2){acc[ai][0][m][n][2 * hh], acc[ai][0][m][n][2 * hh + 1]}, h2) * k256 + bgh[n][hh];
                        h2 up = __builtin_convertvector((f32x2){acc[ai][1][m][n][2 * hh], acc[ai][1][m][n][2 * hh + 1]}, h2) * k256 + buh[n][hh];
                        g = __builtin_elementwise_min(g, seven); up = __builtin_elementwise_min(__builtin_elementwise_max(up, msix), eight);
                        const h2 t = g * cexp; h2 e; e.x = __builtin_exp2f16(t.x); e.y = __builtin_exp2f16(t.y);
                        const h2 d = e + one; h2 r; r.x = __builtin_amdgcn_rcph(d.x); r.y = __builtin_amdgcn_rcph(d.y);
                        const h2 a = up * (g * r);
                        pk = hh ? __builtin_amdgcn_cvt_scalef32_pk_fp8_f16(pk, a, 1.0f, true) : __builtin_amdgcn_cvt_scalef32_pk_fp8_f16(pk, a, 1.0f, false); }
                    w[n] = __builtin_bit_cast(unsigned, pk); }
                *(GAS u32x2*)ap = (u32x2){w[0], w[1]};
                ap += 16 * DE;
                asm volatile("" : "+v"(ap)); }
            ap += 64 * DE; }
    }
};
struct ProbDown {
    typedef MoeUnit Unit;
    MoeSched S; const unsigned char* WT; const float* gatel; const LAS int* cnt; const float* bd; unsigned char* Y;
    __device__ __forceinline__ bool next(int i, Unit& u) const { return S.next(i, u); }
    static constexpr bool GATHER = false;
    __device__ __forceinline__ int arow(const Unit& u) const { return u.pm * 256; }
    __device__ __forceinline__ void aidx(const Unit&, const int (&)[2], int (&)[2][2]) const {}
    __device__ __forceinline__ void acalc(const int (&)[2][2], const int (&)[2], unsigned (&)[2][2]) const {}
    __device__ __forceinline__ const char* bbase(const Unit& u) const { return (const char*)WT + ((size_t)u.e * 1024 + (size_t)u.pn * 256) * DE; }
    __device__ __forceinline__ void epi(const f32x4 (&acc)[2][2][4][2], const Unit& u, int wr, int wc, int fr, int fq) const {
        const int col0 = u.pn * 256 + wc * 64 + 16 * fq; const int n = cnt[u.e];
        const float* b = bd + (size_t)u.e * DM + col0;
        const f32x4 b00 = *(const f32x4*)b, b01 = *(const f32x4*)(b + 4), b10 = *(const f32x4*)(b + 8), b11 = *(const f32x4*)(b + 12);
        const GAS float* gl = (const GAS float*)gatel + (size_t)u.e * ECAP + u.mt * 256;
        const int rmax = n - 1 - u.mt * 256;
        float gtv[8];
#pragma unroll
        for (int q = 0; q < 8; ++q) { const int r = (q >> 2) * 128 + wr * 64 + (q & 3) * 16 + fr; const float g = gl[r < rmax ? r : rmax]; gtv[q] = (r <= rmax) ? g * 16.f : 0.f; }
        GAS unsigned char* yp = (GAS unsigned char*)Y + ((size_t)u.pm * 256 + wr * 64 + fr) * DM + col0;
#pragma unroll
        for (int ai = 0; ai < 2; ++ai) {
#pragma unroll
            for (int m = 0; m < 4; ++m) { const float gt = gtv[ai * 4 + m]; unsigned w[4];
#pragma unroll
                for (int bj = 0; bj < 2; ++bj) { const f32x4 v0 = (acc[ai][bj][m][0] * 0.00390625f + (bj ? b10 : b00)) * gt, v1 = (acc[ai][bj][m][1] * 0.00390625f + (bj ? b11 : b01)) * gt;
                    w[2 * bj] = pk4_fp8(clamp448(v0[0]), clamp448(v0[1]), clamp448(v0[2]), clamp448(v0[3])); w[2 * bj + 1] = pk4_fp8(clamp448(v1[0]), clamp448(v1[1]), clamp448(v1[2]), clamp448(v1[3])); }
                *(GAS u32x4*)yp = (u32x4){w[0], w[1], w[2], w[3]};
                yp += 16 * DM;
                asm volatile("" : "+v"(yp)); }
            yp += 64 * DM; }
    }
};

__device__ __forceinline__ float log_sigmoid(float z) { return __builtin_fminf(z, 0.f) - log1pf(__expf(-__builtin_fabsf(z))); }
__device__ __forceinline__ int t5_bucket(int n) {
    if (n < 16) return n;
    const float nf = (float)n;
    int large = 16 + (int)(logf(nf / 16.f) / logf(128.f / 16.f) * 16.f);
    return large < 31 ? large : 31;
}

__global__ void __launch_bounds__(NWAVES * 64, 2) hymba_fwd(Args args) {
    extern __shared__ __attribute__((aligned(16))) unsigned char lds_raw[];
    LAS unsigned char* lds = (LAS unsigned char*)lds_raw;
    volatile LAS unsigned* MISC = (volatile LAS unsigned*)(lds + MISC_OFF);
    const int tid = threadIdx.x, lane = tid & 63, wave = __builtin_amdgcn_readfirstlane(tid >> 6);
    const int G = gridDim.x; const int bx = blockIdx.x; const int vcu = (G % 8 == 0) ? (bx % 8) * (G / 8) + bx / 8 : bx;
    unsigned char* ws = args.ws;
    unsigned* ctl = (unsigned*)(ws + WS_CTL);
    bf16_t* WinT = (bf16_t*)(ws + WS_WIN); bf16_t* WoT = (bf16_t*)(ws + WS_WO); bf16_t* KX = (bf16_t*)(ws + WS_KX);
    float* C2F = (float*)(ws + WS_C2F); float* LOGF = (float*)(ws + WS_LOGF);
    int* TOKL = (int*)(ws + WS_TOKL); float* GATEL = (float*)(ws + WS_GATEL); int* SLOT = (int*)(ws + WS_SLOT);
    unsigned char* WugT = ws + WS_WUG; unsigned char* WdT = ws + WS_WD; bf16_t* HN = (bf16_t*)(ws + WS_HN); unsigned char* HN8 = ws + WS_HN;
    bf16_t* QKV = (bf16_t*)(ws + WS_QKV); bf16_t* AO = (bf16_t*)(ws + WS_AO); unsigned char* ACT = ws + WS_ACT; unsigned char* YB = ws + WS_Y; bf16_t* PROJ = (bf16_t*)(ws + WS_PROJ);
    for (int u = tid; u < 256; u += NWAVES * 64) MISC[u] = 0u;
    __syncthreads();
    XcdBarrier bar = xcd_barrier_post(ctl + CW_BAR + args.li * XCD_BAR_WORDS, MISC + 8);
    const int lo = args.ph_lo, hi_ph = args.ph_hi;
#ifndef DUP_MASK
#define DUP_MASK 0
#endif
#define NREP(k) ((((DUP_MASK) >> (k)) & 1) + 1)
#ifdef ONLY_PHASE
#define IN(k) ((k) == ONLY_PHASE && lo <= (k) && (k) < hi_ph)
#else
#define IN(k) (lo <= (k) && (k) < hi_ph)
#endif
#define BOTH(k) (IN(k) && IN((k) + 1))
    const int gw = vcu * NWAVES + wave, NGW = G * NWAVES;

    if (IN(0)) {
      for (int rep = 0; rep < NREP(0); ++rep) {
        LAS float* scr = (LAS float*)(lds + wave * 16384);
        constexpr int I_IN = 16 * (NPROJ / 32), I_O = 16 * 32;
        constexpr int NITEMS = I_IN + I_O;
        for (int it = gw; it < NITEMS; it += NGW) {
            int r = it;
            if (r < I_IN) { const int kb = r / (NPROJ / 32), nb = r % (NPROJ / 32), n0 = nb * 32; transpose_item(args.w_in, DM, INW, kb * 64, n0 + (n0 >= 1536 ? 8 : 0), WinT, n0, scr, lane); continue; } r -= I_IN;
            { const int kb = r / 32, nb = r % 32; transpose_item(args.w_out, DM, DM, kb * 64, nb * 32, WoT, nb * 32, scr, lane); }
        }
        __syncthreads();
        LAS float* wfT = (LAS float*)lds;
        { float tmpw[16];
#pragma unroll
          for (int it = 0; it < 16; ++it) { const int i = tid + it * NWAVES * 64; tmpw[it] = args.w_in[(size_t)(i >> 3) * INW + 1536 + (i & 7)]; }
#pragma unroll
          for (int it = 0; it < 16; ++it) { const int i = tid + it * NWAVES * 64; wfT[(i & 7) * DM + (i >> 3)] = tmpw[it]; } }
        __syncthreads();
        f32x4 gm[4];
#pragma unroll
        for (int j = 0; j < 4; ++j) gm[j] = *(const f32x4*)(args.norm_mix + 4 * lane + 256 * j);
        const float bfl = args.b_forget[lane >> 3];
        f32x4 vn[4], vn2[4];
        { const GAS f32x4* xr = (const GAS f32x4*)(args.x + (size_t)gw * DM) + lane;
#pragma unroll
          for (int j = 0; j < 4; ++j) vn[j] = xr[64 * j];
          const GAS f32x4* xr2 = (const GAS f32x4*)(args.x + (size_t)(gw + NGW < NTOK ? gw + NGW : gw) * DM) + lane;
#pragma unroll
          for (int j = 0; j < 4; ++j) vn2[j] = xr2[64 * j]; }
        for (int m = gw; m < NTOK; m += NGW) {
            f32x4 v[4]; float s = 0.f;
#pragma unroll
            for (int j = 0; j < 4; ++j) { v[j] = vn[j]; vn[j] = vn2[j]; }
            if (m + 2 * NGW < NTOK) { const GAS f32x4* xr = (const GAS f32x4*)(args.x + (size_t)(m + 2 * NGW) * DM) + lane;
#pragma unroll
                for (int j = 0; j < 4; ++j) vn2[j] = xr[64 * j]; }
#pragma unroll
            for (int j = 0; j < 4; ++j) s += (v[j].x * v[j].x + v[j].y * v[j].y) + (v[j].z * v[j].z + v[j].w * v[j].w);
            const float rstd = 1.f / sqrtf(wave_sum(s) * (1.f / DM) + EPS);
            GAS u32x2* o8 = (GAS u32x2*)(HN + (size_t)m * DM) + lane;
            float fl[8];
#pragma unroll
            for (int h = 0; h < 8; ++h) fl[h] = 0.f;
#pragma unroll
            for (int j = 0; j < 4; ++j) { v[j] = v[j] * rstd * gm[j]; o8[64 * j] = (u32x2){cvtpk(v[j].x, v[j].y), cvtpk(v[j].z, v[j].w)};
#pragma unroll
                for (int h = 0; h < 8; ++h) { const f32x4 w = *(const LAS f32x4*)(wfT + h * DM + 4 * lane + 256 * j); float t_ = fl[h];
                    t_ = __builtin_fmaf(v[j].x, w.x, t_); t_ = __builtin_fmaf(v[j].y, w.y, t_); t_ = __builtin_fmaf(v[j].z, w.z, t_); t_ = __builtin_fmaf(v[j].w, w.w, t_); fl[h] = t_; } }
#define DPPF(x, ctrl) __builtin_bit_cast(float, __builtin_amdgcn_update_dpp(0, __builtin_bit_cast(int, (x)), (ctrl), 0xF, 0xF, false))
#pragma unroll
            for (int j = 0; j < 4; ++j) { const auto r_ = __builtin_amdgcn_permlane32_swap(__float_as_uint(fl[j]), __float_as_uint(fl[4 + j]), false, false); fl[j] = __uint_as_float(r_[0]) + __uint_as_float(r_[1]); }
#pragma unroll
            for (int j = 0; j < 2; ++j) { const auto r_ = __builtin_amdgcn_permlane16_swap(__float_as_uint(fl[j]), __float_as_uint(fl[2 + j]), false, false); fl[j] = __uint_as_float(r_[0]) + __uint_as_float(r_[1]); }
            { const bool up = (lane & 8) != 0; const float snd = up ? fl[0] : fl[1]; const float keep = up ? fl[1] : fl[0]; fl[0] = keep + DPPF(snd, 0x128); }
            float z = fl[0]; z += DPPF(z, 0x141); z += DPPF(z, 0x4E); z += DPPF(z, 0xB1);
#undef DPPF
            if ((lane & 7) == 0) { z += bfl;
                const int b = m / SEQ, s_ = m % SEQ; LOGF[(size_t)(b * FH + (lane >> 3)) * SEQ + s_] = log_sigmoid(z); }
        }
        __syncthreads();
      }
        if (BOTH(0)) xcd_barrier(bar);
    }

    if (IN(1)) {
        for (int sq = (G == 256 ? bx - 128 : bx); sq >= 0 && sq < NB * FH; sq += G) {
            LAS double* part = (LAS double*)(lds + AUX_OFF);
            const float* lf = LOGF + (size_t)sq * SEQ + tid * 8;
            const f32x4 a0 = *(const f32x4*)lf, a1 = *(const f32x4*)(lf + 4);
            double v[8] = {a0.x, a0.y, a0.z, a0.w, a1.x, a1.y, a1.z, a1.w};
#pragma unroll
            for (int i = 1; i < 8; ++i) v[i] += v[i - 1];
            double incl = v[7];
#pragma unroll
            for (int o = 1; o < 64; o <<= 1) { const double t = __shfl_up(incl, o); if (lane >= o) incl += t; }
            if (lane == 63) part[wave] = incl;
            __syncthreads();
            double base = incl - v[7];
            for (int w = 0; w < wave; ++w) base += part[w];
            float c2v[8];
#pragma unroll
            for (int i = 0; i < 8; ++i) c2v[i] = (float)((base + v[i]) * (double)LOG2E);
            float* co = C2F + (size_t)sq * SEQ + tid * 8;
            *(f32x4*)co = (f32x4){c2v[0], c2v[1], c2v[2], c2v[3]}; *(f32x4*)(co + 4) = (f32x4){c2v[4], c2v[5], c2v[6], c2v[7]};
            bf16_t* kx = KX + ((size_t)sq * SEQ + tid * 8) * 8;
#pragma unroll
            for (int i = 0; i < 8; ++i) { const float nv = -c2v[i];
                const unsigned h0 = cvtpk(nv, 0.f) & 0xffffu; const float r1 = nv - bf2f((unsigned short)h0);
                const unsigned h1 = cvtpk(r1, 0.f) & 0xffffu; const float r2 = r1 - bf2f((unsigned short)h1);
                const unsigned h2 = cvtpk(r2, 0.f) & 0xffffu;
                *(GAS u32x4*)(kx + i * 8) = (u32x4){h0 | (h1 << 16), h2, 0u, 0u}; }
            __syncthreads();
        }
        ProbIn P{G, bx, WinT, QKV, args.qnf, args.knf, args.qns, args.kns};
        pg8::gemm_phase<2, false, ProbIn>(lds, (const char*)HN, DM * 2, P);
        if (G == 256 && bx >= 128) cv_unit(bx - 128, args.w_ug, args.w_down, WugT, WdT, (LAS float*)lds + wave * 1152, wave, lane);
        if (BOTH(1)) xcd_barrier(bar);
    }

    if (IN(2)) {
        LAS char* shm = (LAS char*)lds;
        { float tbv[4];
#pragma unroll
          for (int it = 0; it < 4; ++it) { const int i = tid + it * NWAVES * 64; const int h = i >> 8, d = (i & 255) - 64; const int dc = d < 0 ? 0 : d > 127 ? 127 : d;
              const float v = args.rel_bias[t5_bucket(dc) * SH + h]; tbv[it] = (d >= 0 && d < 128) ? v * LOG2E : -INFINITY; }
#pragma unroll
          for (int it = 0; it < 4; ++it) ((LAS float*)(shm + att::LDS_TB))[tid + it * NWAVES * 64] = tbv[it]; }
        float gq = 0.f, gk = 0.f, gqs_ = 0.f, gks_ = 0.f;
        { const float* gp = wave == 0 ? args.qnf : wave == 1 ? args.knf : wave == 2 ? args.qns : args.kns;
          float v = (tid < 256) ? __builtin_fabsf(gp[lane]) : 0.f;
#pragma unroll
          for (int o_ = 1; o_ < 64; o_ <<= 1) v = __builtin_fmaxf(v, __shfl_xor(v, o_));
          if (lane == 0) ((volatile LAS float*)MISC)[28 + wave] = v;
          __syncthreads();
          gq = ((volatile LAS float*)MISC)[28]; gk = ((volatile LAS float*)MISC)[29]; gqs_ = ((volatile LAS float*)MISC)[30]; gks_ = ((volatile LAS float*)MISC)[31]; }
        const float thr2 = 150.f + 2.f * (C2 * 64.f * gq * gk * 1.02f) + 1.f;
        float mb = 0.f;
        { float v = (tid < 32 * SH) ? args.rel_bias[tid] : 0.f;
#pragma unroll
          for (int o_ = 1; o_ < 64; o_ <<= 1) v = __builtin_fmaxf(v, __shfl_xor(v, o_));
          if (lane == 0) ((volatile LAS float*)MISC)[24 + wave] = v;
          __syncthreads();
          for (int w = 0; w < 4; ++w) mb = __builtin_fmaxf(mb, ((volatile LAS float*)MISC)[24 + w]); }
        const bool fox_nomax = (C2 * 64.f * gq * gk * 1.02f + 0.5f <= att::THR);
        const bool swa_nomax = (C2 * 64.f * gqs_ * gks_ * 1.02f + mb * LOG2E + 0.5f <= att::THR);
        __syncthreads();
        constexpr int NFOX = NB * FH * (SEQ / 256), NSWA = NB * SKV * (SEQ / 64);
        static_assert((NFOX + NSWA) == 2 * CV_UNITS, "queue interleave: two attention units per conversion unit");
      for (int rep = 0; rep < NREP(2); ++rep)
        for (;;) {
            if (tid == 0) MISC[16] = atomicAdd(ctl + CW_QUEUE + 64 * rep, 1u);
            __syncthreads();
            const int uq = (int)MISC[16];
            int u;
            if (G == 256) {
                if (uq >= 128 * 23) break;
                if (uq < 128 * 15) {
                    const int grp = uq / 15, r = uq % 15;
                    if (r & 1) { cv_unit(128 + grp * 7 + (r >> 1), args.w_ug, args.w_down, WugT, WdT, (LAS float*)(lds + 98304) + wave * 1152, wave, lane); __syncthreads(); continue; }
                    u = grp * 8 + (r >> 1);
                } else u = NFOX + (uq - 128 * 15);
            } else {
                if (uq >= NFOX + NSWA + CV_UNITS) break;
                if (uq % 3 == 2) { cv_unit(uq / 3, args.w_ug, args.w_down, WugT, WdT, (LAS float*)(lds + 98304) + wave * 1152, wave, lane); __syncthreads(); continue; }
                u = (uq / 3) * 2 + uq % 3; }
            att::UnitArgs A;
            if (u < NFOX) {
                const int qb = (SEQ / 256 - 1) - u / (NB * FH), bh = u % (NB * FH), b = bh / FH, h = bh % FH;
                const int q0 = qb * 256;
                const float* c2 = C2F + (size_t)bh * SEQ;
                const float cq0 = c2[q0];
                const int tl = lane;
                const bool keep = (tl <= 4 * qb + 3) && (cq0 - c2[tl * 64 + 63] >= -thr2);
                const unsigned long long mk = __ballot(keep);
                int T0 = mk ? (int)__builtin_ctzll(mk) : 4 * qb; if (T0 > 4 * qb) T0 = 4 * qb; T0 = __builtin_amdgcn_readfirstlane(T0);
                const float cqw = c2[q0 + wave * 32];
                const unsigned long long mkw = __ballot((tl <= 4 * qb + 3) && (cqw - c2[tl * 64 + 63] >= -thr2));
                int T0w = mkw ? (int)__builtin_ctzll(mkw) : T0; if (T0w < T0) T0w = T0; if (T0w > 4 * qb) T0w = 4 * qb; T0w = __builtin_amdgcn_readfirstlane(T0w);
                const size_t rowb = (size_t)b * SEQ;
                A.Qw = QKV + (rowb + q0 + wave * 32) * QKVP + COL_FQ + h * HD;
                A.Kh = QKV + (rowb + T0 * 64) * QKVP + COL_FK + h * HD;
                A.Vh = QKV + (rowb + T0 * 64) * QKVP + COL_FV + h * HD;
                A.kx = KX + ((size_t)bh * SEQ + T0 * 64) * 8;
                A.Ow = AO + (rowb + q0 + wave * 32) * DM + h * HD;
                A.nt = 4 * qb + 4 - T0; A.nomax = fox_nomax; A.t_first = T0w - T0; A.qw_rel = q0 + wave * 32 - T0 * 64; A.tb_off = 0; A.sink2 = __builtin_bit_cast(float, __builtin_amdgcn_readfirstlane(__builtin_bit_cast(int, cqw)));
                att::attn_unit<true>(A, shm);
            } else {
                const int v = u - NFOX, blk = v % (SEQ / 64), bk = v / (SEQ / 64), kvh = bk % SKV, b = bk / SKV;
                const int q0 = blk * 64, T0 = blk >= 2 ? blk - 2 : 0, hq = kvh * 4 + (wave >> 1), qw = q0 + (wave & 1) * 32;
                const size_t rowb = (size_t)b * SEQ;
                A.Qw = QKV + (rowb + qw) * QKVP + COL_SQ + hq * HD;
                A.Kh = QKV + (rowb + T0 * 64) * QKVP + COL_SK + kvh * HD;
                A.Vh = QKV + (rowb + T0 * 64) * QKVP + COL_SV + kvh * HD;
                A.kx = nullptr;
                A.Ow = AO + (rowb + qw) * DM + 512 + hq * HD;
                A.nt = blk + 1 - T0; A.nomax = swa_nomax; A.t_first = 0; A.qw_rel = qw - T0 * 64; A.tb_off = att::LDS_TB + hq * 1024; A.sink2 = args.sinks[hq] * LOG2E;
                att::attn_unit<false>(A, shm);
            }
        }
        if (BOTH(2)) xcd_barrier(bar);
    }

    if (IN(3)) {
        ProbOut P{G, bx, WoT, PROJ};
        pg8::gemm_phase<1, false, ProbOut>(lds, (const char*)AO, DM * 2, P);
        if (BOTH(3)) xcd_barrier(bar);
    }

    if (IN(4)) {
        LAS float* wrT = (LAS float*)lds;
        for (int kk = 0; kk < 2; ++kk) { const int k = tid + 512 * kk;
            f32x4 r[8];
#pragma unroll
            for (int q = 0; q < 8; ++q) r[q] = *(const f32x4*)(args.w_router + (size_t)k * NE + 4 * q);
#pragma unroll
            for (int q = 0; q < 8; ++q)
#pragma unroll
                for (int c = 0; c < 4; ++c) wrT[(4 * q + c) * DM + k] = r[q][c]; }
        LAS float* lg = (LAS float*)(lds + AUX_OFF) + wave * 512;
        LAS int* tokE = (LAS int*)(lds + TOKS_OFF);
        LAS float* tokG = (LAS float*)(lds + TOKS_OFF + 2048);
        LAS int* hist = (LAS int*)(lds + MISC_OFF + 128);
        LAS int* hbase = (LAS int*)(lds + MISC_OFF + 256);
        LAS int* hrun = (LAS int*)(lds + MISC_OFF + 384);
        f32x4 gm[4];
#pragma unroll
        for (int j = 0; j < 4; ++j) gm[j] = *(const f32x4*)(args.norm_moe + 4 * lane + 256 * j);
        float brl[4];
#pragma unroll
        for (int ec = 0; ec < 4; ++ec) brl[ec] = args.b_router[ec * 8 + (lane >> 3)];
        __syncthreads();
        for (int chunk = vcu; chunk < NTOK / 128; chunk += G) {
            if (tid < 32) { hist[tid] = 0; hrun[tid] = 0; }
            __syncthreads();
            const int tok0 = chunk * 128 + wave * 16;
#pragma unroll 1
            for (int it = 0; it < 4; ++it) {
                f32x4 v[4][4];
                { u32x2 pn_[4][4];
#pragma unroll
                  for (int tt = 0; tt < 4; ++tt) { const size_t ro = (size_t)(tok0 + 4 * it + tt) * DM;
                      const GAS f32x4* xr = (const GAS f32x4*)(args.x + ro) + lane; const GAS u32x2* pr = (const GAS u32x2*)(PROJ + ro) + lane;
#pragma unroll
                      for (int j = 0; j < 4; ++j) { v[tt][j] = xr[64 * j]; pn_[tt][j] = pr[64 * j]; } }
#pragma unroll
                  for (int tt = 0; tt < 4; ++tt)
#pragma unroll
                      for (int j = 0; j < 4; ++j) { const u32x2 p = pn_[tt][j]; v[tt][j] += (f32x4){__builtin_bit_cast(float, p.x << 16), __builtin_bit_cast(float, p.x & 0xffff0000u), __builtin_bit_cast(float, p.y << 16), __builtin_bit_cast(float, p.y & 0xffff0000u)}; } }
#pragma unroll
                for (int tt = 0; tt < 4; ++tt) { GAS u32x2* hw = (GAS u32x2*)(PROJ + (size_t)(tok0 + 4 * it + tt) * DM) + lane;
#pragma unroll
                    for (int j = 0; j < 4; ++j) hw[64 * j] = (u32x2){cvtpk(v[tt][j].x, v[tt][j].y), cvtpk(v[tt][j].z, v[tt][j].w)}; }
#pragma unroll
                for (int tt = 0; tt < 4; ++tt) { float s = 0.f;
#pragma unroll
                    for (int j = 0; j < 4; ++j) s += (v[tt][j].x * v[tt][j].x + v[tt][j].y * v[tt][j].y) + (v[tt][j].z * v[tt][j].z + v[tt][j].w * v[tt][j].w);
                    const float rs = 1.f / sqrtf(wave_sum(s) * (1.f / DM) + EPS);
                    GAS unsigned* o4 = (GAS unsigned*)(HN8 + (size_t)(tok0 + 4 * it + tt) * DM) + lane;
#pragma unroll
                    for (int j = 0; j < 4; ++j) { v[tt][j] = v[tt][j] * rs * gm[j]; o4[64 * j] = pk4_fp8(v[tt][j].x, v[tt][j].y, v[tt][j].z, v[tt][j].w); } }
#pragma unroll 1
                for (int ec = 0; ec < 4; ++ec) {
                    const float brl_ec = ec == 0 ? brl[0] : ec == 1 ? brl[1] : ec == 2 ? brl[2] : brl[3];
                    float a[4][8];
#pragma unroll
                    for (int e = 0; e < 8; ++e) {
#pragma unroll
                        for (int tt = 0; tt < 4; ++tt) a[tt][e] = 0.f;
#pragma unroll
                        for (int j = 0; j < 4; ++j) { const f32x4 w = *(const LAS f32x4*)(wrT + (ec * 8 + e) * DM + 4 * lane + 256 * j);
#pragma unroll
                            for (int tt = 0; tt < 4; ++tt) { float t_ = a[tt][e];
                                t_ = __builtin_fmaf(v[tt][j].x, w.x, t_); t_ = __builtin_fmaf(v[tt][j].y, w.y, t_); t_ = __builtin_fmaf(v[tt][j].z, w.z, t_); t_ = __builtin_fmaf(v[tt][j].w, w.w, t_); a[tt][e] = t_; } }
                        if (e & 1) asm volatile("" ::: "memory"); }
#define RS_SW32(P, N) _Pragma("unroll") for (int j = 0; j < (N); ++j) { const auto r_ = __builtin_amdgcn_permlane32_swap(__float_as_uint(P[j]), __float_as_uint(P[(N) + j]), false, false); P[j] = __uint_as_float(r_[0]) + __uint_as_float(r_[1]); }
#define RS_SW16(P, N) _Pragma("unroll") for (int j = 0; j < (N); ++j) { const auto r_ = __builtin_amdgcn_permlane16_swap(__float_as_uint(P[j]), __float_as_uint(P[(N) + j]), false, false); P[j] = __uint_as_float(r_[0]) + __uint_as_float(r_[1]); }
#define DPPF(x, ctrl) __builtin_bit_cast(float, __builtin_amdgcn_update_dpp(0, __builtin_bit_cast(int, (x)), (ctrl), 0xF, 0xF, false))
#pragma unroll
                    for (int tt = 0; tt < 4; ++tt) { RS_SW32(a[tt], 4) RS_SW16(a[tt], 2)
                        { const bool up = (lane & 8) != 0; const float snd = up ? a[tt][0] : a[tt][1]; const float keep = up ? a[tt][1] : a[tt][0]; a[tt][0] = keep + DPPF(snd, 0x128); }
                        float sfull = a[tt][0]; sfull += DPPF(sfull, 0x141); sfull += DPPF(sfull, 0x4E); sfull += DPPF(sfull, 0xB1);
                        if ((lane & 7) == 0) { const int e = ec * 8 + (lane >> 3); lg[(4 * it + tt) * 32 + e] = sfull + brl_ec; } }
#undef RS_SW32
#undef RS_SW16
#undef DPPF
                }
            }
            LDS_WAIT();
            int tidl = tid; asm volatile("" : "+v"(tidl));
            const int lanel = tidl & 63;
            if (lanel < 16) {
                float l[32];
#pragma unroll
                for (int e = 0; e < 32; ++e) l[e] = lg[lanel * 32 + e];
                int ei[4]; float ev[4];
#pragma unroll
                for (int k = 0; k < 4; ++k) { float bv = -INFINITY; int bi = 0;
#pragma unroll
                    for (int e = 0; e < 32; ++e) { const bool gt = l[e] > bv; bv = gt ? l[e] : bv; bi = gt ? e : bi; }
                    ei[k] = bi; ev[k] = bv;
#pragma unroll
                    for (int e = 0; e < 32; ++e) l[e] = (e == bi) ? -INFINITY : l[e]; }
                float ex[4], sum = 0.f;
#pragma unroll
                for (int k = 0; k < 4; ++k) { ex[k] = __expf(ev[k] - ev[0]); sum += ex[k]; }
                const float inv = 1.f / sum; const int tl = wave * 16 + lanel;
#pragma unroll
                for (int k = 0; k < 4; ++k) { tokE[tl * 4 + k] = ei[k]; tokG[tl * 4 + k] = ex[k] * inv; __hip_atomic_fetch_add(hist + ei[k], 1, __ATOMIC_RELAXED, __HIP_MEMORY_SCOPE_WORKGROUP); }
            }
            __syncthreads();
            if (tidl < 32) hbase[tidl] = (int)atomicAdd(ctl + CW_CNT + 64 * tidl, (unsigned)hist[tidl]);
            __syncthreads();
            { const int tl = tidl >> 2, k = tidl & 3, e = tokE[tidl]; const int pos = hbase[e] + __hip_atomic_fetch_add(hrun + e, 1, __ATOMIC_RELAXED, __HIP_MEMORY_SCOPE_WORKGROUP);
              const int tok = chunk * 128 + tl;
              TOKL[(size_t)e * ECAP + pos] = tok; GATEL[(size_t)e * ECAP + pos] = tokG[tidl]; SLOT[tok * 4 + k] = e * ECAP + pos; }
            __syncthreads();
        }
        if (BOTH(4)) xcd_barrier(bar);
    }

    LAS int* ecnt = (LAS int*)(lds + MISC_OFF + 512);
    LAS int* tstart = (LAS int*)(lds + MISC_OFF + 640);
    if (IN(5) || IN(6) || IN(7)) {
        if (tid < 64) {
            const int e = lane & 31;
            const int n = (int)__hip_atomic_load(ctl + CW_CNT + 64 * e, __ATOMIC_RELAXED, __HIP_MEMORY_SCOPE_AGENT);
            int incl = (n + 255) >> 8;
#pragma unroll
            for (int o = 1; o < 32; o <<= 1) { const int t = __shfl_up(incl, o, 32); if (e >= o) incl += t; }
            if (lane < 32) { ecnt[e] = n; tstart[e] = incl - ((n + 255) >> 8); if (e == 31) tstart[NE] = incl; } }
        __syncthreads();
    }
    if (IN(5)) {
        MoeSched S{G, bx, tstart[NE], 8, tstart};
        ProbUp P{S, WugT, TOKL, ecnt, args.b_ug, ACT};
        for (int rep = 0; rep < NREP(5); ++rep) pg8::gemm_phase<1, true, ProbUp>(lds, (const char*)HN8, DM, P);
        if (BOTH(5)) xcd_barrier(bar);
    }
    if (IN(6)) {
        MoeSched S{G, bx, tstart[NE], 4, tstart};
        ProbDown P{S, WdT, GATEL, ecnt, args.b_down, YB};
        for (int rep = 0; rep < NREP(6); ++rep) pg8::gemm_phase<3, true, ProbDown>(lds, (const char*)ACT, DE, P);
        if (BOTH(6)) xcd_barrier(bar);
    }

    if (IN(7)) {
        for (int b0 = gw * 16; b0 < NTOK; b0 += NGW * 16) {
            const int sl = SLOT[b0 * 4 + lane]; const int se = sl / ECAP; const int rowv = tstart[se] * 256 + (sl - se * ECAP);
            f32x4 xa[4], xb[4]; u32x2 pa[4], pb[4]; unsigned ya[4][4], yb[4][4];
#define P7_LOAD(X, P, Y, t) do { const size_t ro = (size_t)(b0 + (t)) * DM; const GAS u32x2* pr = (const GAS u32x2*)(PROJ + ro) + lane; \
                _Pragma("unroll") for (int k = 0; k < 4; ++k) { const size_t yr = (size_t)__builtin_amdgcn_readlane(rowv, 4 * (t) + k) * DM; \
                    _Pragma("unroll") for (int j = 0; j < 4; ++j) Y[k][j] = *((const GAS unsigned*)(YB + yr) + lane + 64 * j); } \
                _Pragma("unroll") for (int j = 0; j < 4; ++j) { P[j] = pr[64 * j]; } } while (0)
#define P7_COMP(X, P, Y, t) do { GAS f32x4* orow = (GAS f32x4*)(args.out + (size_t)(b0 + (t)) * DM) + lane; \
                _Pragma("unroll") for (int j = 0; j < 4; ++j) { f32x4 sacc = {0.f, 0.f, 0.f, 0.f}; \
                    _Pragma("unroll") for (int k = 0; k < 4; ++k) { const f32x2 lo2 = __builtin_amdgcn_cvt_pk_f32_fp8((int)Y[k][j], false), hi2 = __builtin_amdgcn_cvt_pk_f32_fp8((int)Y[k][j], true); \
                        sacc.x += lo2.x; sacc.y += lo2.y; sacc.z += hi2.x; sacc.w += hi2.y; } \
                    const f32x4 pf = {__builtin_bit_cast(float, P[j].x << 16), __builtin_bit_cast(float, P[j].x & 0xffff0000u), __builtin_bit_cast(float, P[j].y << 16), __builtin_bit_cast(float, P[j].y & 0xffff0000u)}; \
                    orow[64 * j] = pf + sacc * (1.f / 16.f); } } while (0)
            P7_LOAD(xa, pa, ya, 0);
#pragma unroll 1
            for (int t = 0; t < 16; t += 2) {
                P7_LOAD(xb, pb, yb, t + 1);
                P7_COMP(xa, pa, ya, t);
                if (t + 2 < 16) P7_LOAD(xa, pa, ya, t + 2);
                P7_COMP(xb, pb, yb, t + 1);
            }
#undef P7_LOAD
#undef P7_COMP
        }
    }
#undef IN
#undef BOTH
}

#ifndef N_LAUNCH_CUTS
#define N_LAUNCH_CUTS 1
#endif
extern "C" void kernel_launch(void* const* d_in, const int* in_sizes, int n_in, void* d_out, int out_size, void* d_ws, size_t ws_size, hipStream_t stream) {
    static int grid = 0;
    if (grid == 0) {
        if (n_in != 18 || out_size != NTOK * DM || ws_size < WS_END) { fprintf(stderr, "kernel_launch: unexpected shapes (n_in %d out %d ws %zu)\n", n_in, out_size, ws_size); grid = -1; return; }
        int dev = 0, cus = 0, per_cu = 0;
        if (hipGetDevice(&dev) != hipSuccess || hipDeviceGetAttribute(&cus, hipDeviceAttributeMultiprocessorCount, dev) != hipSuccess) { grid = -1; return; }
        if (hipFuncSetAttribute((const void*)hymba_fwd, hipFuncAttributeMaxDynamicSharedMemorySize, LDS_BYTES) != hipSuccess) { fprintf(stderr, "kernel_launch: hipFuncSetAttribute failed\n"); grid = -1; return; }
        if (hipOccupancyMaxActiveBlocksPerMultiprocessor(&per_cu, (const void*)hymba_fwd, NWAVES * 64, LDS_BYTES) != hipSuccess || per_cu < 1) { fprintf(stderr, "kernel_launch: occupancy query says %d\n", per_cu); }
        (void)hipGetLastError();
        grid = cus;
    }
    if (grid < 0) return;
    (void)hipMemsetAsync((char*)d_ws + WS_CTL, 0, CTL_ZERO_BYTES, stream);
    Args a{};
    a.x = (const float*)d_in[0]; a.norm_mix = (const float*)d_in[1]; a.w_in = (const float*)d_in[2]; a.b_forget = (const float*)d_in[3];
    a.qnf = (const float*)d_in[4]; a.knf = (const float*)d_in[5]; a.qns = (const float*)d_in[6]; a.kns = (const float*)d_in[7];
    a.sinks = (const float*)d_in[8]; a.rel_bias = (const float*)d_in[9]; a.w_out = (const float*)d_in[10]; a.norm_moe = (const float*)d_in[11];
    a.w_router = (const float*)d_in[12]; a.b_router = (const float*)d_in[13]; a.w_ug = (const float*)d_in[14]; a.b_ug = (const float*)d_in[15];
    a.w_down = (const float*)d_in[16]; a.b_down = (const float*)d_in[17]; a.out = (float*)d_out; a.ws = (unsigned char*)d_ws;
    constexpr int NPH = 8;
    if (N_LAUNCH_CUTS == 1) { a.ph_lo = 0; a.ph_hi = NPH; a.li = 0; hipLaunchKernelGGL(hymba_fwd, dim3(grid), dim3(NWAVES * 64), LDS_BYTES, stream, a); }
    else for (int p = 0; p < NPH; ++p) { a.ph_lo = p; a.ph_hi = p + 1; a.li = 0; hipLaunchKernelGGL(hymba_fwd, dim3(grid), dim3(NWAVES * 64), LDS_BYTES, stream, a); }
}
```

```cpp
#include <hip/hip_runtime.h>
#include <hip/hip_bf16.h>
#include <cstdio>
#include <cstdint>

#define LAS __attribute__((address_space(3)))
#define GAS __attribute__((address_space(1)))
typedef unsigned short bf16_t;
typedef short bf16x8 __attribute__((ext_vector_type(8)));
typedef short s16x4 __attribute__((ext_vector_type(4)));
typedef float f32x4 __attribute__((ext_vector_type(4)));
typedef float f32x2 __attribute__((ext_vector_type(2)));
typedef float f32x16 __attribute__((ext_vector_type(16)));
typedef unsigned u32x4 __attribute__((ext_vector_type(4)));
typedef unsigned u32x2 __attribute__((ext_vector_type(2)));
typedef __bf16 bf16x2_t __attribute__((ext_vector_type(2)));

constexpr int DM = 1024, NB = 8, SEQ = 4096, NTOK = NB * SEQ;
constexpr int HD = 64, FH = 8, SH = 8, SKV = 2;
constexpr int INW = 2312, NPROJ = 2304;
constexpr int QKVP = NPROJ;
constexpr int COL_FQ = 0, COL_FK = 512, COL_FV = 1024, COL_SQ = 1536, COL_SK = 2048, COL_SV = 2176;
constexpr int NE = 32, TOPK = 4, DE = 1024;
constexpr int ECAP = 32768;
constexpr int MOE_ROWS = NTOK * TOPK + NE * 256;
constexpr float EPS = 1e-6f;
constexpr float LOG2E = 1.4426950408889634f;
constexpr float C2 = 0.125f * LOG2E;

__device__ __forceinline__ unsigned cvtpk(float lo, float hi) { f32x2 v = {lo, hi}; bf16x2_t b = __builtin_convertvector(v, bf16x2_t); return __builtin_bit_cast(unsigned, b); }
__device__ __forceinline__ unsigned pk4_fp8(float a, float b, float c, float d) { int r = 0; r = __builtin_amdgcn_cvt_pk_fp8_f32(a, b, r, false); r = __builtin_amdgcn_cvt_pk_fp8_f32(c, d, r, true); return (unsigned)r; }
__device__ __forceinline__ float clamp448(float v) { return __builtin_amdgcn_fmed3f(v, -448.f, 448.f); }
__device__ __forceinline__ float bf2f(unsigned short h) { return __builtin_bit_cast(float, (unsigned)h << 16); }

namespace pg8 {
constexpr int BM = 256, BK = 64, HALF = 128, HTB = HALF * BK * 2, STAGE_BYTES = 8 * HTB, NXCD = 8, WGM = 8;
__host__ __device__ __forceinline__ int lds_byte(int r, int c) { const int st = (r >> 4) * 2 + (c >> 5), rr = r & 15, cc = c & 31, ob = rr * 64 + cc * 2; return st * 1024 + (ob ^ (((ob >> 9) & 1) << 5)); }
__host__ __device__ __forceinline__ void stage_rc(int b, int& R, int& C) { const int st = b / 1024, sb = b % 1024, swz = sb ^ (((sb >> 9) & 1) << 5); R = (st >> 1) * 16 + swz / 64; C = (st & 1) * 32 + (swz % 64) / 2; }
__host__ __device__ __forceinline__ int perm32(int rho) { const int n = rho >> 4, i = rho & 15; return 8 * (i >> 2) + 4 * n + (i & 3); }

struct Tile { int pm, pn; };
typedef int v8i32 __attribute__((ext_vector_type(8)));
typedef int v4i32 __attribute__((ext_vector_type(4)));
__device__ __forceinline__ v8i32 cat8(bf16x8 a, bf16x8 b) { return __builtin_shufflevector(__builtin_bit_cast(v4i32, a), __builtin_bit_cast(v4i32, b), 0, 1, 2, 3, 4, 5, 6, 7); }
__device__ __forceinline__ bool static_tile(int i, int G, int c, int nM, int nN, Tile& u) {
    const int nwg = nM * nN; const long L = (long)i * G + c; if (L >= nwg) return false;
    int wgid = (int)L; { const int q = nwg / NXCD, r = nwg % NXCD, xcd = wgid % NXCD, off = wgid / NXCD; wgid = (xcd < r ? xcd * (q + 1) : r * (q + 1) + (xcd - r) * q) + off; }
    const int nig = WGM * nN, gid = wgid / nig, fm = gid * WGM, gsz = (nM - fm) < WGM ? (nM - fm) : WGM;
    u.pm = fm + ((wgid % nig) % gsz); u.pn = (wgid % nig) / gsz; return true;
}
template <int BMODE> __host__ __device__ __forceinline__ int brow(int R) { return BMODE == 0 ? R : BMODE == 1 ? ((R & ~31) + perm32(R & 31)) : BMODE == 2 ? (64 * (R >> 5) + perm32(R & 31)) : (64 * (R >> 5) + 16 * ((R >> 2) & 3) + 4 * ((R >> 4) & 1) + (R & 3)); }

template <int BMODE, bool FP8, class Prob>
__device__ __forceinline__ void gemm_phase(LAS unsigned char* lds, const char* Abase, const int KB, const Prob& S) {
    typedef typename Prob::Unit Unit;
    const int tid = threadIdx.x, wid = __builtin_amdgcn_readfirstlane(tid >> 6), lane = tid & 63, wr = wid >> 2, wc = wid & 3, fr = lane & 15, fq = lane >> 4;
    const int nt = KB / 128;
    int Rl[2], Cl[2]; unsigned voffB[2];
#pragma unroll
    for (int i = 0; i < 2; ++i) { int R, C; stage_rc(tid * 16 + i * 8192, R, C); Rl[i] = R; Cl[i] = C; voffB[i] = (unsigned)(brow<BMODE>(R) * KB + C * 2); }
    const size_t kstep = (size_t)(BK * 2);
    const size_t hstepB = (size_t)(BMODE == 2 ? 32 : BMODE == 3 ? 8 : HALF) * KB;
    const unsigned ldsw = (unsigned)wid * 1024u;
    const int aoff = lds_byte(wr * 64 + fr, fq * 8), boff = lds_byte(wc * 32 + fr, fq * 8);
#define PG8_SA(b, h) (((b) * 2 + (h)) * HTB)
#define PG8_SB(b, h) ((4 + (b) * 2 + (h)) * HTB)
#define PG8_STAGE(bufoff, gbase, voff) do { const char* gb_ = (const char*)(gbase); asm volatile("" : "+s"(gb_));   \
        _Pragma("unroll") for (int _i = 0; _i < 2; ++_i) \
        __builtin_amdgcn_global_load_lds((const unsigned*)(gb_ + (voff)[_i]), (LAS unsigned*)(lds + (bufoff) + ldsw + _i * 8192), 16, 0, 0); } while (0)
#define PG8_LDA(dst, b, h) do { _Pragma("unroll") for (int m = 0; m < 4; ++m) _Pragma("unroll") for (int k = 0; k < 2; ++k) dst[m][k] = *(const LAS bf16x8*)(lds + PG8_SA(b, h) + aoff + m * 2048 + k * 1024); } while (0)
#define PG8_LDB(dst, b, h) do { _Pragma("unroll") for (int n = 0; n < 2; ++n) _Pragma("unroll") for (int k = 0; k < 2; ++k) dst[n][k] = *(const LAS bf16x8*)(lds + PG8_SB(b, h) + boff + n * 2048 + k * 1024); } while (0)
#define PG8_MMA(ai, bj, At, Bt) do { __builtin_amdgcn_s_setprio(1); if constexpr (FP8) { _Pragma("unroll") for (int m = 0; m < 4; ++m) _Pragma("unroll") for (int n = 0; n < 2; ++n) { \
            const v8i32 fa = cat8(At[m][0], At[m][1]), fb = cat8(Bt[n][0], Bt[n][1]); \
            asm volatile("v_mfma_f32_16x16x128_f8f6f4 %0, %1, %2, %0" : "+v"(acc[ai][bj][m][n]) : "v"(fb), "v"(fa)); } } \
        else { _Pragma("unroll") for (int m = 0; m < 4; ++m) _Pragma("unroll") for (int n = 0; n < 2; ++n) _Pragma("unroll") for (int k = 0; k < 2; ++k) \
            acc[ai][bj][m][n] = __builtin_amdgcn_mfma_f32_16x16x32_bf16(Bt[n][k], At[m][k], acc[ai][bj][m][n], 0, 0, 0); } __builtin_amdgcn_s_setprio(0); } while (0)
#define PG8_WAIT_V(n) asm volatile("s_waitcnt vmcnt(" #n ")" ::: "memory")
#define PG8_WAIT_L(n) asm volatile("s_waitcnt lgkmcnt(" #n ")" ::: "memory")
#define PG8_BAR __builtin_amdgcn_s_barrier()
#define PG8_SCHED __builtin_amdgcn_sched_barrier(0)
    Unit cur, nxt; int ui = 0;
    if (!S.next(0, cur)) return;
    f32x4 acc[2][2][4][2];
#pragma unroll
    for (int a = 0; a < 2; ++a)
#pragma unroll
        for (int b = 0; b < 2; ++b)
#pragma unroll
            for (int m = 0; m < 4; ++m)
#pragma unroll
                for (int n = 0; n < 2; ++n) acc[a][b][m][n] = (f32x4){0.f, 0.f, 0.f, 0.f};
    bf16x8 At[4][2], B0[2][2], B1[2][2];
    constexpr bool GA = Prob::GATHER;
    unsigned oC[2][2], o2[2][2], voffA[2];
    const char* cA = Abase; const char* nA = Abase;
    const size_t hstepA = (size_t)HALF * KB;
    int tkN[2][2];
    if constexpr (GA) { S.aidx(cur, Rl, tkN); S.acalc(tkN, Cl, oC); }
    else {
#pragma unroll
        for (int i = 0; i < 2; ++i) voffA[i] = (unsigned)(Rl[i] * KB + Cl[i] * 2);
        cA = Abase + (size_t)S.arow(cur) * KB; }
#define PG8_STAGE_A(bufoff, pg, kb, h, og) do { if constexpr (GA) { PG8_STAGE(bufoff, Abase + (kb), og[h]); } else { PG8_STAGE(bufoff, (pg) + (kb) + (h) * hstepA, voffA); } } while (0)
    const char* cB = S.bbase(cur);
    PG8_STAGE(PG8_SB(0, 0), cB, voffB); PG8_STAGE(PG8_SB(0, 1), cB + hstepB, voffB); PG8_STAGE_A(PG8_SA(0, 0), cA, 0, 0, oC); PG8_STAGE_A(PG8_SA(0, 1), cA, 0, 1, oC);
    if (wr == 1) PG8_BAR;
    PG8_WAIT_V(2); PG8_BAR;
    PG8_STAGE(PG8_SB(1, 0), cB + kstep, voffB); PG8_STAGE_A(PG8_SA(1, 0), cA, kstep, 0, oC); PG8_STAGE(PG8_SB(1, 1), cB + hstepB + kstep, voffB);
    PG8_WAIT_V(6); PG8_BAR;
    for (;;) {
        const bool has_next = S.next(ui + 1, nxt);
        const char* nB = cB; nA = cA;
        if (has_next) { nB = S.bbase(nxt); if constexpr (!GA) nA = Abase + (size_t)S.arow(nxt) * KB; }
#pragma unroll 1
        for (int t = 0; t < nt; t += 2) {
            const bool last = (t == nt - 2);
            const size_t k1 = (size_t)(t + 1) * kstep, k2 = last ? 0 : (size_t)(t + 2) * kstep, k3 = k2 + kstep;
            const char* p2 = last ? nA : cA; const char* b2 = last ? nB : cB + (size_t)(t + 2) * kstep; const char* b3 = b2 + kstep;
            if constexpr (GA) {
                if (t == nt - 4 && has_next) { int Rr[2], Cc[2]; int t2 = tid; asm volatile("" : "+v"(t2)); stage_rc(t2 * 16, Rr[0], Cc[0]); stage_rc(t2 * 16 + 8192, Rr[1], Cc[1]); S.aidx(nxt, Rr, tkN); }
#pragma unroll
                for (int h = 0; h < 2; ++h)
#pragma unroll
                    for (int i = 0; i < 2; ++i) o2[h][i] = oC[h][i];
                if (last) {
                    if (has_next) { int Rr[2], Cc[2]; int t2 = tid; asm volatile("" : "+v"(t2)); stage_rc(t2 * 16, Rr[0], Cc[0]); stage_rc(t2 * 16 + 8192, Rr[1], Cc[1]); S.acalc(tkN, Cc, o2); }
                    asm volatile("" : "+v"(o2[0][0]), "+v"(o2[0][1]), "+v"(o2[1][0]), "+v"(o2[1][1]));
                } }
            asm volatile("" : "+v"(voffB[0]), "+v"(voffB[1]));
            if constexpr (GA) asm volatile("" : "+v"(oC[0][0]), "+v"(oC[0][1]), "+v"(oC[1][0]), "+v"(oC[1][1]), "+v"(o2[0][0]), "+v"(o2[0][1]), "+v"(o2[1][0]), "+v"(o2[1][1]));
            else asm volatile("" : "+v"(voffA[0]), "+v"(voffA[1]));
            PG8_LDB(B0, 0, 0); PG8_LDB(B1, 0, 1); PG8_SCHED; PG8_LDA(At, 0, 0); PG8_STAGE_A(PG8_SA(1, 1), cA, k1, 1, oC);
            PG8_WAIT_V(8); PG8_WAIT_L(0); PG8_BAR; PG8_MMA(0, 0, At, B0); PG8_MMA(0, 1, At, B1); PG8_BAR; PG8_SCHED;
            PG8_LDA(At, 0, 1); PG8_STAGE(PG8_SB(0, 0), b2, voffB); PG8_STAGE(PG8_SB(0, 1), b2 + hstepB, voffB); PG8_STAGE_A(PG8_SA(0, 0), p2, k2, 0, o2);
            PG8_WAIT_V(8); PG8_WAIT_L(0); PG8_BAR; PG8_MMA(1, 0, At, B0); PG8_MMA(1, 1, At, B1); PG8_BAR; PG8_SCHED;
            PG8_LDB(B0, 1, 0); PG8_LDB(B1, 1, 1); PG8_SCHED; PG8_LDA(At, 1, 0); PG8_STAGE_A(PG8_SA(0, 1), p2, k2, 1, o2);
            PG8_WAIT_V(8); PG8_WAIT_L(0); PG8_BAR; PG8_MMA(0, 0, At, B0); PG8_MMA(0, 1, At, B1); PG8_BAR; PG8_SCHED;
            PG8_LDA(At, 1, 1); PG8_STAGE(PG8_SB(1, 0), b3, voffB); PG8_STAGE(PG8_SB(1, 1), b3 + hstepB, voffB); PG8_STAGE_A(PG8_SA(1, 0), p2, k3, 0, o2);
            PG8_WAIT_V(8); PG8_WAIT_L(0); PG8_BAR; PG8_MMA(1, 0, At, B0); PG8_MMA(1, 1, At, B1); PG8_BAR; PG8_SCHED;
        }
        if (wr == 0) PG8_BAR;
        if constexpr (FP8) asm volatile("s_nop 15\n\ts_nop 15" ::: "memory");
        S.epi(acc, cur, wr, wc, fr, fq);
        if (!has_next) break;
#pragma unroll
        for (int a = 0; a < 2; ++a)
#pragma unroll
            for (int b = 0; b < 2; ++b)
#pragma unroll
                for (int m = 0; m < 4; ++m)
#pragma unroll
                    for (int n = 0; n < 2; ++n) acc[a][b][m][n] = (f32x4){0.f, 0.f, 0.f, 0.f};
        cur = nxt; cB = nB; cA = nA; ++ui;
        if constexpr (GA) {
#pragma unroll
            for (int h = 0; h < 2; ++h)
#pragma unroll
                for (int i = 0; i < 2; ++i) oC[h][i] = o2[h][i]; }
        if (wr == 1) PG8_BAR;
    }
    PG8_WAIT_V(0);
    PG8_BAR;
#undef PG8_SA
#undef PG8_SB
#undef PG8_STAGE
#undef PG8_STAGE_A
#undef PG8_LDA
#undef PG8_LDB
#undef PG8_MMA
#undef PG8_WAIT_V
#undef PG8_WAIT_L
#undef PG8_BAR
#undef PG8_SCHED
}
}

namespace att {
typedef LAS const char* lds_cptr;
typedef short v4i16_t __attribute__((ext_vector_type(4)));
constexpr int NSLOT = 3, SLOTB = 8192;
constexpr int LDS_K = 0, LDS_V = NSLOT * SLOTB, LDS_WS = 2 * NSLOT * SLOTB, LDS_OST = LDS_WS + 8 * 256, LDS_TB = LDS_OST + 8 * 4096, LDS_KX = LDS_TB + 8 * 256 * 4, LDS_END = LDS_KX + NSLOT * 1024;
constexpr float THR = 20.f;
#define SBAR() __builtin_amdgcn_sched_barrier(0)
__device__ __forceinline__ int crow(int r, int hi) { return (r & 3) + 8 * (r >> 2) + 4 * hi; }
__device__ __forceinline__ void glds16(const void* gsrc, unsigned lds_dst) { unsigned keep;
    asm volatile("s_mov_b32 %0, m0\n\ts_mov_b32 m0, %2\n\ts_nop 0\n\tglobal_load_lds_dwordx4 %1, off\n\ts_mov_b32 m0, %0" : "=&s"(keep) : "v"(gsrc), "s"(lds_dst) : "memory"); }
__device__ __forceinline__ void glds16s(unsigned voff, const char* sbase, unsigned lds_dst) { unsigned keep;
    asm volatile("s_mov_b32 %0, m0\n\ts_mov_b32 m0, %3\n\ts_nop 0\n\tglobal_load_lds_dwordx4 %1, %2\n\ts_mov_b32 m0, %0" : "=&s"(keep) : "v"(voff), "s"(sbase), "s"(lds_dst) : "memory"); }
#define MFMA32(a, b, c) __builtin_amdgcn_mfma_f32_32x32x16_bf16(a, b, c, 0, 0, 0)
__device__ __forceinline__ void k_load(bf16x8 (&kf)[8], lds_cptr kb) {
#pragma unroll
    for (int d0 = 0; d0 < 4; ++d0) { kf[2 * d0] = *(const LAS bf16x8*)(kb + d0 * 2048); kf[2 * d0 + 1] = *(const LAS bf16x8*)(kb + d0 * 2048 + 512); }
}
__device__ __forceinline__ void qkt(f32x16& p0, f32x16& p1, const bf16x8 (&kf)[8], const bf16x8* qr, const f32x16& negm) {
    p0 = MFMA32(kf[0], qr[0], negm); p1 = MFMA32(kf[1], qr[0], negm);
#pragma unroll
    for (int d0 = 1; d0 < 4; ++d0) { p0 = MFMA32(kf[2 * d0], qr[d0], p0); p1 = MFMA32(kf[2 * d0 + 1], qr[d0], p1); }
}
__device__ __forceinline__ float rowmax(const f32x16& p0, const f32x16& p1) {
    float a = __builtin_fmaxf(p0[0], p1[0]);
#pragma unroll
    for (int r = 1; r < 16; ++r) a = __builtin_fmaxf(__builtin_fmaxf(a, p0[r]), p1[r]);
    auto rr = __builtin_amdgcn_permlane32_swap(__float_as_uint(a), __float_as_uint(a), false, false);
    return __builtin_fmaxf(__uint_as_float(rr[0]), __uint_as_float(rr[1]));
}
__device__ __forceinline__ s16x4 vtr(lds_cptr p) { return __builtin_bit_cast(s16x4, __builtin_amdgcn_ds_read_tr16_b64_v4i16((LAS v4i16_t*)p)); }
__device__ __forceinline__ void v_load(s16x4 (&lo)[8], s16x4 (&hi)[8], lds_cptr vp) {
#pragma unroll
    for (int i = 0; i < 8; ++i) { lo[i] = vtr(vp + ((i >> 2) * 4096 + (i & 3) * 1024)); hi[i] = vtr(vp + ((i >> 2) * 4096 + (i & 3) * 1024 + 512)); }
}
__device__ __forceinline__ void pv_mma(f32x16* o, const s16x4 (&lo)[8], const s16x4 (&hi)[8], bf16x8 pa0, bf16x8 pa1, bf16x8 pa2, bf16x8 pa3) {
#define VFR(i) (bf16x8){lo[i][0], lo[i][1], lo[i][2], lo[i][3], hi[i][0], hi[i][1], hi[i][2], hi[i][3]}
    o[0] = MFMA32(pa0, VFR(0), o[0]); o[1] = MFMA32(pa0, VFR(4), o[1]);
    o[0] = MFMA32(pa1, VFR(1), o[0]); o[1] = MFMA32(pa1, VFR(5), o[1]);
    o[0] = MFMA32(pa2, VFR(2), o[0]); o[1] = MFMA32(pa2, VFR(6), o[1]);
    o[0] = MFMA32(pa3, VFR(3), o[0]); o[1] = MFMA32(pa3, VFR(7), o[1]);
#undef VFR
    const bf16x8 ones = __builtin_bit_cast(bf16x8, (u32x4){0x3F803F80u, 0x3F803F80u, 0x3F803F80u, 0x3F803F80u});
    o[2] = MFMA32(pa0, ones, o[2]); o[2] = MFMA32(pa1, ones, o[2]); o[2] = MFMA32(pa2, ones, o[2]); o[2] = MFMA32(pa3, ones, o[2]);
}

struct UnitArgs {
    const bf16_t* Qw;
    const bf16_t* Kh;
    const bf16_t* Vh;
    const bf16_t* kx;
    bf16_t* Ow;
    int nt;
    bool nomax;
    int t_first;
    int qw_rel;
    int tb_off;
    float sink2;
};
template <bool FOX> __device__ __forceinline__ void attn_unit(const UnitArgs& A, LAS char* shm) {
    const int tid = threadIdx.x, lane = tid & 63, r32 = lane & 31, hi = lane >> 5; const int wid = __builtin_amdgcn_readfirstlane(tid >> 6);
    const unsigned lds0 = (unsigned)(uintptr_t)shm;
    LAS float* wsf = (LAS float*)(shm + LDS_WS) + wid * 64;
    const bf16_t* ksrc = A.Kh + (long)lane * QKVP + wid * 8;
    const bf16_t* vsrc = A.Vh + (long)(16 * (wid & 3) + (lane >> 2)) * QKVP + (wid >> 2) * 32 + (lane & 3) * 8;
    const unsigned kdst = lds0 + LDS_K + wid * 1024, vdst = lds0 + LDS_V + wid * 1024, xdst = lds0 + LDS_KX;
    const bf16_t* xsrc = A.kx + (long)lane * 8;
    const unsigned koff = (unsigned)(lane * QKVP + wid * 8) * 2u, voffs = (unsigned)((16 * (wid & 3) + (lane >> 2)) * QKVP + (wid >> 2) * 32 + (lane & 3) * 8) * 2u, xoff = (unsigned)lane * 16u;
    const char* kbase = (const char*)A.Kh; const char* vbase = (const char*)A.Vh; const char* xbase = (const char*)A.kx;
    asm volatile("" : "+s"(kbase), "+s"(vbase), "+s"(xbase));
#define DMA_K(t, slot) glds16s(koff, kbase + (long)(t) * (64 * QKVP * 2), (unsigned)__builtin_amdgcn_readfirstlane(kdst + (slot)))
#define DMA_V(t, slot) glds16s(voffs, vbase + (long)(t) * (64 * QKVP * 2), (unsigned)__builtin_amdgcn_readfirstlane(vdst + (slot)))
#define DMA_X(t, slot) glds16s(xoff, xbase + (long)(t) * (64 * 8 * 2), (unsigned)__builtin_amdgcn_readfirstlane(xdst + ((slot) >> 3)))
    const lds_cptr vp0 = (lds_cptr)shm + LDS_V + ((lane >> 4) & 1) * 32 + (lane & 3) * 8 + (4 * hi + ((lane & 15) >> 2)) * 64;
    const lds_cptr kp0 = (lds_cptr)shm + LDS_K + hi * 1024 + r32 * 16;
    const int nt = A.nt;
    DMA_K(0, 0); DMA_V(0, 0); if (FOX) DMA_X(0, 0);
    bf16x8 qr[4];
#pragma unroll
    for (int d0 = 0; d0 < 4; ++d0) qr[d0] = *(const GAS bf16x8*)(A.Qw + (long)r32 * QKVP + d0 * 16 + hi * 8);
    const u32x4 one3 = {0x3F803F80u, 0x00003F80u, 0u, 0u}, zero4 = {0u, 0u, 0u, 0u};
    const bf16x8 qx0 = __builtin_bit_cast(bf16x8, hi == 0 ? one3 : zero4), qx1 = __builtin_bit_cast(bf16x8, hi == 1 ? one3 : zero4);
    float m_ref = 0.f; f32x16 o[3]; o[0] = f32x16{}; o[1] = f32x16{}; o[2] = f32x16{}; f32x16 negm = f32x16{};
    if (FOX) { m_ref = -A.sink2;
#pragma unroll
        for (int r = 0; r < 16; ++r) negm[r] = A.sink2; }
    const int qrel = A.qw_rel + r32;
    int sl_cur = 0, sl_next = SLOTB;
    asm volatile("s_waitcnt vmcnt(0)" : "+v"(qr[0]), "+v"(qr[1]), "+v"(qr[2]), "+v"(qr[3]) :: "memory");
    for (int t = 0; t < nt; ++t) {
        if (t + 1 < nt) {
            DMA_K(t + 1, sl_next); DMA_V(t + 1, sl_next);
            if (FOX) { DMA_X(t + 1, sl_next); asm volatile("s_waitcnt vmcnt(3) lgkmcnt(0)\n\ts_barrier" ::: "memory"); }
            else asm volatile("s_waitcnt vmcnt(2) lgkmcnt(0)\n\ts_barrier" ::: "memory");
        } else asm volatile("s_waitcnt vmcnt(0) lgkmcnt(0)\n\ts_barrier" ::: "memory");
        const int kv0 = t * 64;
        const bool active = FOX ? (t >= A.t_first && kv0 <= A.qw_rel + 31) : true;
        if (active) {
            f32x16 p0, p1;
            bf16x8 kf[8]; s16x4 vlo[8], vhi[8];
            k_load(kf, kp0 + sl_cur);
            v_load(vlo, vhi, vp0 + sl_cur);
            SBAR();
            __builtin_amdgcn_s_setprio(1);
            qkt(p0, p1, kf, qr, negm);
            if (FOX) {
                const bf16x8 kxf = *(const LAS bf16x8*)(shm + LDS_KX + (sl_cur >> 3) + lane * 16);
                p0 = MFMA32(kxf, qx0, p0); p1 = MFMA32(kxf, qx1, p1);
                if (kv0 + 63 > A.qw_rel) {
#pragma unroll
                    for (int r = 0; r < 16; ++r) { const int kv = kv0 + crow(r, hi); if (kv > qrel) p0[r] = -INFINITY; if (kv + 32 > qrel) p1[r] = -INFINITY; }
                }
            } else {
                const LAS float* tb = (const LAS float*)(shm + A.tb_off);
#pragma unroll
                for (int r = 0; r < 16; ++r) { const int ix = qrel - (kv0 + crow(r, hi)) + 64; p0[r] += tb[ix]; p1[r] += tb[ix - 32]; }
            }
            __builtin_amdgcn_s_setprio(0);
            const bool need_max = !A.nomax || (FOX && kv0 + 63 > A.qw_rel);
            const float rm = need_max ? rowmax(p0, p1) : 0.f;
            if (need_max && __any(rm > THR)) {
                const float dl = __builtin_fmaxf(rm, 0.f); m_ref += dl; const float al = __builtin_amdgcn_exp2f(-dl);
#pragma unroll
                for (int r = 0; r < 16; ++r) { p0[r] -= dl; p1[r] -= dl; negm[r] = -m_ref; }
                if (hi == 0) wsf[r32] = al;
                asm volatile("s_waitcnt lgkmcnt(0)" ::: "memory");
#pragma unroll
                for (int j = 0; j < 4; ++j) { const f32x4 f = *(const LAS f32x4*)(wsf + 8 * j + 4 * hi);
#pragma unroll
                    for (int i = 0; i < 4; ++i) { o[0][4 * j + i] *= f[i]; o[1][4 * j + i] *= f[i]; o[2][4 * j + i] *= f[i]; } }
            }
#pragma unroll
            for (int r = 0; r < 16; ++r) { p0[r] = __builtin_amdgcn_exp2f(p0[r]); p1[r] = __builtin_amdgcn_exp2f(p1[r]); }
            const u32x4 pw0 = {cvtpk(p0[0], p0[1]), cvtpk(p0[2], p0[3]), cvtpk(p0[4], p0[5]), cvtpk(p0[6], p0[7])};
            const u32x4 pw1 = {cvtpk(p0[8], p0[9]), cvtpk(p0[10], p0[11]), cvtpk(p0[12], p0[13]), cvtpk(p0[14], p0[15])};
            const u32x4 pw2 = {cvtpk(p1[0], p1[1]), cvtpk(p1[2], p1[3]), cvtpk(p1[4], p1[5]), cvtpk(p1[6], p1[7])};
            const u32x4 pw3 = {cvtpk(p1[8], p1[9]), cvtpk(p1[10], p1[11]), cvtpk(p1[12], p1[13]), cvtpk(p1[14], p1[15])};
            SBAR();
            __builtin_amdgcn_s_setprio(1);
            pv_mma(o, vlo, vhi, __builtin_bit_cast(bf16x8, pw0), __builtin_bit_cast(bf16x8, pw1), __builtin_bit_cast(bf16x8, pw2), __builtin_bit_cast(bf16x8, pw3));
            __builtin_amdgcn_s_setprio(0);
        }
        sl_cur = sl_next; sl_next = (sl_next == (NSLOT - 1) * SLOTB) ? 0 : sl_next + SLOTB;
    }
    float rli[16];
    if (!FOX) {
        if (hi == 0) wsf[32 + r32] = __builtin_amdgcn_exp2f(A.sink2 - m_ref);
        asm volatile("s_waitcnt lgkmcnt(0)" ::: "memory");
#pragma unroll
        for (int r = 0; r < 16; ++r) rli[r] = __builtin_amdgcn_rcpf(o[2][r] + wsf[32 + crow(r, hi)]);
    } else {
#pragma unroll
        for (int r = 0; r < 16; ++r) rli[r] = __builtin_amdgcn_rcpf(o[2][r]);
    }
    { LAS bf16_t* stg = (LAS bf16_t*)(shm + LDS_OST) + wid * 2048;
#pragma unroll
      for (int r = 0; r < 16; ++r) { const int orow = crow(r, hi);
#pragma unroll
          for (int d0 = 0; d0 < 2; ++d0) stg[orow * 64 + d0 * 32 + r32] = (bf16_t)(cvtpk(o[d0][r] * rli[r], 0.f) & 0xffffu); }
      asm volatile("s_waitcnt lgkmcnt(0)" ::: "memory");
#pragma unroll
      for (int i = 0; i < 4; ++i) { const int row = i * 8 + (lane >> 3), ch = lane & 7; const u32x4 v = *(const LAS u32x4*)(stg + row * 64 + ch * 8); *(GAS u32x4*)(A.Ow + (long)row * DM + ch * 8) = v; } }
    asm volatile("s_waitcnt vmcnt(0) lgkmcnt(0)\n\ts_barrier" ::: "memory");
#undef DMA_K
#undef DMA_V
#undef DMA_X
}
#undef SBAR
}

constexpr size_t MiB = 1u << 20;
constexpr size_t WS_CTL = 0, CTL_ZERO_BYTES = 64 * 1024;
constexpr size_t WS_WIN = 2 * MiB;
constexpr size_t WS_WO = 7 * MiB;
constexpr size_t WS_KX = 9 * MiB;
constexpr size_t WS_C2F = 13 * MiB;
constexpr size_t WS_LOGF = 14 * MiB;
constexpr size_t WS_TOKL = 16 * MiB;
constexpr size_t WS_GATEL = 20 * MiB;
constexpr size_t WS_SLOT = 24 * MiB;
constexpr size_t WS_WUG = 32 * MiB;
constexpr size_t WS_WD = 160 * MiB;
constexpr size_t WS_HN = 224 * MiB;
constexpr size_t WS_QKV = 288 * MiB;
constexpr size_t WS_AO = 432 * MiB;
constexpr size_t WS_ACT = 288 * MiB;
constexpr size_t WS_Y = 560 * MiB;
constexpr size_t WS_PROJ = 704 * MiB;
constexpr size_t WS_END = 832 * MiB;
static_assert(WS_ACT + (size_t)MOE_ROWS * DE <= WS_Y && WS_Y + (size_t)MOE_ROWS * DM <= WS_PROJ && WS_PROJ + (size_t)NTOK * DM * 2 <= WS_END, "ws map");
constexpr int CW_TMO = 0, CW_QUEUE = 64, CW_CNT = 1024  , CW_BAR = 4096;

constexpr int RING_BYTES = 131072;
constexpr int AUX_OFF = RING_BYTES;
constexpr int TOKS_OFF = AUX_OFF + 16384;
constexpr int MISC_OFF = TOKS_OFF + 4096;
constexpr int LDS_BYTES = MISC_OFF + 1024;
constexpr int NWAVES = 8;

#define XB_TMO      128
#define XB_XCNT(j)  (256  + 64 * (j))
#define XB_XSUB(j)  (1280 + 64 * (j))
#define XB_XGEN(j)  (2304 + 64 * (j))
#define XB_TOP      3328
#define XB_TOPGEN   3392
#define XCD_BAR_WORDS 3456
#define XB_SPIN_CAP (1u << 18)
__device__ __forceinline__ unsigned xb_ld(unsigned* p)              { return __hip_atomic_load(p, __ATOMIC_RELAXED, __HIP_MEMORY_SCOPE_AGENT); }
__device__ __forceinline__ unsigned xb_add(unsigned* p, unsigned v) { return __hip_atomic_fetch_add(p, v, __ATOMIC_RELAXED, __HIP_MEMORY_SCOPE_AGENT); }
__device__ __forceinline__ unsigned xb_xcc_id() { return (unsigned)__builtin_amdgcn_s_getreg((3 << 11) | 20) & 0xFu; }
#define XB_SPIN(cond, bar) do { unsigned _sp = 0; while (cond) { __builtin_amdgcn_s_sleep(1); \
    if ((++_sp & 255u) == 0u) { if (xb_ld(&(bar)[XB_TMO])) break; if (_sp > XB_SPIN_CAP) { atomicAdd(&(bar)[XB_TMO], 1u); break; } } } } while (0)
struct XcdBarrier { unsigned* bar; unsigned x; volatile LAS unsigned* st; };
__device__ __forceinline__ XcdBarrier xcd_barrier_post(unsigned* bar, volatile LAS unsigned* st) {
    XcdBarrier b; b.bar = bar; b.x = xb_xcc_id(); b.st = st;
    if (threadIdx.x == 0) (void)xb_add(&bar[XB_XCNT(b.x)], 1u);
    return b;
}
__device__ __forceinline__ void xcd_barrier_complete(unsigned* bar, unsigned x, unsigned& nloc, unsigned& nx) {
    const unsigned G = gridDim.x * gridDim.y * gridDim.z;
    unsigned sum, cnt, mine, sp = 0u;
    for (;;) {
        sum = 0u; cnt = 0u; mine = 0u;
#pragma unroll
        for (unsigned j = 0; j < 16; ++j) { const unsigned c = xb_ld(&bar[XB_XCNT(j)]); sum += c; cnt += (c > 0u) ? 1u : 0u; mine = (j == x) ? c : mine; }
        if (sum == G) break;
        __builtin_amdgcn_s_sleep(1);
        if ((++sp & 255u) == 0u) { if (xb_ld(&bar[XB_TMO])) break; if (sp > XB_SPIN_CAP) { atomicAdd(&bar[XB_TMO], 1u); break; } }
    }
    nloc = mine > 0u ? mine : 1u; nx = cnt > 0u ? cnt : 1u;
}
__device__ __forceinline__ void xcd_barrier(const XcdBarrier& b) {
    asm volatile("s_waitcnt vmcnt(0)" ::: "memory");
    __syncthreads();
    if (threadIdx.x == 0) {
        unsigned* bar = b.bar;
        __builtin_amdgcn_s_waitcnt(0);
        unsigned nloc = b.st[0], nx = b.st[1];
        if (nloc == 0u) { xcd_barrier_complete(bar, b.x, nloc, nx); b.st[0] = nloc; b.st[1] = nx; }
        const unsigned old = xb_add(&bar[XB_XSUB(b.x)], 1u);
        const unsigned gen = old / nloc;
        if (old + 1u == (gen + 1u) * nloc) {
            __builtin_amdgcn_fence(__ATOMIC_RELEASE, "agent");
            asm volatile("s_waitcnt vmcnt(0)" ::: "memory");
            const unsigned og = xb_add(&bar[XB_TOP], 1u);
            const unsigned tg = og / nx;
            if (og + 1u == (tg + 1u) * nx) xb_add(&bar[XB_TOPGEN], 1u);
            else XB_SPIN(xb_ld(&bar[XB_TOPGEN]) == tg, bar);
            __builtin_amdgcn_fence(__ATOMIC_ACQUIRE, "agent");
            xb_add(&bar[XB_XGEN(b.x)], 1u);
            asm volatile("s_waitcnt vmcnt(0)" ::: "memory");
        } else {
            XB_SPIN(xb_ld(&bar[XB_XGEN(b.x)]) == gen, bar);
            __builtin_amdgcn_fence(__ATOMIC_ACQUIRE, "agent");
            asm volatile("s_waitcnt vmcnt(0)" ::: "memory");
        }
    }
    __syncthreads();
}

struct Args {
    const float* x; const float* norm_mix; const float* w_in; const float* b_forget; const float* qnf; const float* knf; const float* qns; const float* kns;
    const float* sinks; const float* rel_bias; const float* w_out; const float* norm_moe; const float* w_router; const float* b_router; const float* w_ug; const float* b_ug;
    const float* w_down; const float* b_down; float* out; unsigned char* ws; int ph_lo, ph_hi, li, pad;
};

__device__ __forceinline__ float wave_sum(float v) {
#define WS_DPP(x, ctrl) __builtin_bit_cast(float, __builtin_amdgcn_update_dpp(0, __builtin_bit_cast(int, (x)), (ctrl), 0xF, 0xF, false))
    v += WS_DPP(v, 0xB1); v += WS_DPP(v, 0x4E); v += WS_DPP(v, 0x141); v += WS_DPP(v, 0x140);
#undef WS_DPP
    { const auto r_ = __builtin_amdgcn_permlane16_swap(__float_as_uint(v), __float_as_uint(v), false, false); v = __uint_as_float(r_[0]) + __uint_as_float(r_[1]); }
    { const auto r_ = __builtin_amdgcn_permlane32_swap(__float_as_uint(v), __float_as_uint(v), false, false); v = __uint_as_float(r_[0]) + __uint_as_float(r_[1]); }
    return v;
}
#define LDS_WAIT() asm volatile("s_waitcnt lgkmcnt(0)" ::: "memory")

__device__ __forceinline__ void transpose_item(const float* W, int K, int ldw, int k0, int src_col0, bf16_t* WT, int dst_row0, LAS float* scr, int lane) {
#pragma unroll 8
    for (int i = 0; i < 32; ++i) { const int kk = 2 * i + (lane >> 5); scr[kk * 33 + (lane & 31)] = W[(size_t)(k0 + kk) * ldw + src_col0 + (lane & 31)]; }
    LDS_WAIT(); asm volatile("" ::: "memory");
    const int c = lane & 7;
#pragma unroll
    for (int j = 0; j < 4; ++j) { const int n = (lane >> 3) + 8 * j; const LAS float* s = scr + (8 * c) * 33 + n;
        u32x4 o; o.x = cvtpk(s[0 * 33], s[1 * 33]); o.y = cvtpk(s[2 * 33], s[3 * 33]); o.z = cvtpk(s[4 * 33], s[5 * 33]); o.w = cvtpk(s[6 * 33], s[7 * 33]);
        *(GAS u32x4*)(WT + (size_t)(dst_row0 + n) * K + k0 + 8 * c) = o; }
    LDS_WAIT(); asm volatile("" ::: "memory");
}

__device__ __forceinline__ void transpose_item_fp8(const float* W, int K, int ldw, int k0, int src_col0, unsigned char* WT, int dst_row0, float scale, LAS float* scr, int lane) {
#pragma unroll 8
    for (int i = 0; i < 32; ++i) { const int kk = 2 * i + (lane >> 5); scr[kk * 33 + (lane & 31)] = W[(size_t)(k0 + kk) * ldw + src_col0 + (lane & 31)] * scale; }
    LDS_WAIT(); asm volatile("" ::: "memory");
    const int c = lane & 7;
#pragma unroll
    for (int j = 0; j < 4; ++j) { const int n = (lane >> 3) + 8 * j; const LAS float* s = scr + (8 * c) * 33 + n;
        u32x2 o; o.x = pk4_fp8(s[0 * 33], s[1 * 33], s[2 * 33], s[3 * 33]); o.y = pk4_fp8(s[4 * 33], s[5 * 33], s[6 * 33], s[7 * 33]);
        *(GAS u32x2*)(WT + (size_t)(dst_row0 + n) * K + k0 + 8 * c) = o; }
    LDS_WAIT(); asm volatile("" ::: "memory");
}

constexpr int CV_UG_ITEMS = NE * 8 * 64, CV_D_ITEMS = NE * 8 * 32, CV_ITEMS = CV_UG_ITEMS + CV_D_ITEMS, CV_PER_UNIT = 24, CV_UNITS = CV_ITEMS / CV_PER_UNIT;
static_assert(CV_ITEMS % CV_PER_UNIT == 0, "conversion items per unit");
struct CvItem { const float* src; unsigned char* dst; int ldw; };
__device__ __forceinline__ CvItem cv_item(int it, const float* w_ug, const float* w_down, unsigned char* WugT, unsigned char* WdT) {
    CvItem c;
    if (it < CV_UG_ITEMS) { const int e = it >> 9, q = it & 511, kb = q >> 6, nb = q & 63, n0 = nb * 32;
        const int pn = n0 >> 8, bj = (n0 >> 7) & 1, rho = n0 & 127;
        c.src = w_ug + (size_t)e * DM * 2048 + (size_t)(kb * 128) * 2048 + bj * 1024 + pn * 128 + rho; c.dst = WugT + ((size_t)e * 2048 + n0) * DM + kb * 128; c.ldw = 2048; }
    else { const int r = it - CV_UG_ITEMS, e = r >> 8, q = r & 255, kb = q >> 5, nb = q & 31;
        c.src = w_down + (size_t)e * DE * DM + (size_t)(kb * 128) * DM + nb * 32; c.dst = WdT + ((size_t)e * DM + nb * 32) * DE + kb * 128; c.ldw = DM; }
    return c;
}
__device__ __forceinline__ void cv_load(f32x4 (&v)[16], const CvItem& c, int lane) {
    const GAS float* p = (const GAS float*)c.src + (size_t)(lane >> 3) * c.ldw + 4 * (lane & 7);
#pragma unroll
    for (int i = 0; i < 16; ++i) v[i] = *(const GAS f32x4*)(p + (size_t)(8 * i) * c.ldw);
}
__device__ __forceinline__ void cv_store(const f32x4 (&v)[16], const CvItem& c, LAS float* scr, int lane) {
    const int lk = lane >> 3, ln = lane & 7, n = lane & 31, kh = lane >> 5;
#pragma unroll
    for (int sub = 0; sub < 4; ++sub) {
#pragma unroll
        for (int i = 0; i < 4; ++i) *(LAS f32x4*)(scr + (8 * i + lk) * 36 + 4 * ln) = v[4 * sub + i] * 256.f;
        LDS_WAIT(); asm volatile("" ::: "memory");
        float t[16];
#pragma unroll
        for (int kk = 0; kk < 16; ++kk) t[kk] = clamp448(scr[(16 * kh + kk) * 36 + n]);
        LDS_WAIT(); asm volatile("" ::: "memory");
        const u32x4 o = {pk4_fp8(t[0], t[1], t[2], t[3]), pk4_fp8(t[4], t[5], t[6], t[7]), pk4_fp8(t[8], t[9], t[10], t[11]), pk4_fp8(t[12], t[13], t[14], t[15])};
        *(GAS u32x4*)(c.dst + (size_t)n * 1024 + 32 * sub + 16 * kh) = o;
    }
}
__device__ __forceinline__ void cv_unit(int unit, const float* w_ug, const float* w_down, unsigned char* WugT, unsigned char* WdT, LAS float* scr, int wave, int lane) {
    const int it0 = unit * CV_PER_UNIT + wave * 3;
    const CvItem c0 = cv_item(it0, w_ug, w_down, WugT, WdT), c1 = cv_item(it0 + 1, w_ug, w_down, WugT, WdT), c2 = cv_item(it0 + 2, w_ug, w_down, WugT, WdT);
    f32x4 va[16], vb[16];
    cv_load(va, c0, lane); cv_load(vb, c1, lane);
    cv_store(va, c0, scr, lane);
    cv_load(va, c2, lane);
    cv_store(vb, c1, scr, lane);
    cv_store(va, c2, scr, lane);
}

struct ProbIn {
    typedef pg8::Tile Unit;
    int G, c; const bf16_t* WT; bf16_t* QKV; const float *gqf, *gkf, *gqs, *gks;
    __device__ __forceinline__ bool next(int i, Unit& u) const { return pg8::static_tile(i, G, c, NTOK / 256, NPROJ / 256, u); }
    static constexpr bool GATHER = false;
    __device__ __forceinline__ int arow(const Unit& u) const { return u.pm * 256; }
    __device__ __forceinline__ void aidx(const Unit&, const int (&)[2], int (&)[2][2]) const {}
    __device__ __forceinline__ void acalc(const int (&)[2][2], const int (&)[2], unsigned (&)[2][2]) const {}
    __device__ __forceinline__ const char* bbase(const Unit& u) const { return (const char*)WT + (size_t)u.pn * 256 * DM * 2; }
    __device__ __forceinline__ void epi(const f32x4 (&acc)[2][2][4][2], const Unit& u, int wr, int wc, int fr, int fq) const {
        const int pn = u.pn; const float* g = nullptr; float sc = 1.f;
        if (pn < 2) { g = gqf; sc = C2; } else if (pn < 4) { g = gkf; } else if (pn < 6) { g = nullptr; } else if (pn < 8) { g = gqs; sc = C2; } else { g = (wc < 2) ? gks : nullptr; }
        f32x4 gv[2][2];
#pragma unroll
        for (int bj = 0; bj < 2; ++bj)
#pragma unroll
            for (int n = 0; n < 2; ++n) { const f32x4 gl = *(const f32x4*)((g ? g : gqf) + 32 * bj + 8 * fq + 4 * n); gv[bj][n] = g ? gl * sc : (f32x4){1.f, 1.f, 1.f, 1.f}; }
#pragma unroll
        for (int ai = 0; ai < 2; ++ai)
#pragma unroll
            for (int m = 0; m < 4; ++m) {
                float rs = 1.f;
                if (g) { float ss = 0.f;
#pragma unroll
                    for (int bj = 0; bj < 2; ++bj)
#pragma unroll
                        for (int n = 0; n < 2; ++n) { const f32x4 v = acc[ai][bj][m][n]; ss += (v[0] * v[0] + v[1] * v[1]) + (v[2] * v[2] + v[3] * v[3]); }
                    { const auto r_ = __builtin_amdgcn_permlane16_swap(__float_as_uint(ss), __float_as_uint(ss), false, false); ss = __uint_as_float(r_[0]) + __uint_as_float(r_[1]); }
                    { const auto r_ = __builtin_amdgcn_permlane32_swap(__float_as_uint(ss), __float_as_uint(ss), false, false); ss = __uint_as_float(r_[0]) + __uint_as_float(r_[1]); }
                    rs = __builtin_amdgcn_rsqf(ss * (1.f / 64.f) + EPS); }
                const int row = u.pm * 256 + ai * 128 + wr * 64 + m * 16 + fr;
                bf16_t* rowp = QKV + (size_t)row * QKVP + pn * 256 + wc * 64 + 8 * fq;
#pragma unroll
                for (int bj = 0; bj < 2; ++bj) { const f32x4 v0 = acc[ai][bj][m][0] * rs * gv[bj][0], v1 = acc[ai][bj][m][1] * rs * gv[bj][1];
                    u32x4 w; w.x = cvtpk(v0[0], v0[1]); w.y = cvtpk(v0[2], v0[3]); w.z = cvtpk(v1[0], v1[1]); w.w = cvtpk(v1[2], v1[3]);
                    *(GAS u32x4*)(rowp + 32 * bj) = w; } }
    }
};
struct ProbOut {
    typedef pg8::Tile Unit;
    int G, c; const bf16_t* WT; bf16_t* PROJ;
    __device__ __forceinline__ bool next(int i, Unit& u) const { return pg8::static_tile(i, G, c, NTOK / 256, DM / 256, u); }
    static constexpr bool GATHER = false;
    __device__ __forceinline__ int arow(const Unit& u) const { return u.pm * 256; }
    __device__ __forceinline__ void aidx(const Unit&, const int (&)[2], int (&)[2][2]) const {}
    __device__ __forceinline__ void acalc(const int (&)[2][2], const int (&)[2], unsigned (&)[2][2]) const {}
    __device__ __forceinline__ const char* bbase(const Unit& u) const { return (const char*)WT + (size_t)u.pn * 256 * DM * 2; }
    __device__ __forceinline__ void epi(const f32x4 (&acc)[2][2][4][2], const Unit& u, int wr, int wc, int fr, int fq) const {
        GAS bf16_t* pp = (GAS bf16_t*)PROJ + ((size_t)u.pm * 256 + wr * 64 + fr) * DM + u.pn * 256 + wc * 32 + 8 * fq;
#pragma unroll
        for (int ai = 0; ai < 2; ++ai) {
#pragma unroll
            for (int m = 0; m < 4; ++m) {
#pragma unroll
                for (int bj = 0; bj < 2; ++bj) { const f32x4 v0 = acc[ai][bj][m][0], v1 = acc[ai][bj][m][1];
                    *(GAS u32x4*)(pp + bj * 128) = (u32x4){cvtpk(v0[0], v0[1]), cvtpk(v0[2], v0[3]), cvtpk(v1[0], v1[1]), cvtpk(v1[2], v1[3])}; }
                pp += 16 * DM;
                asm volatile("" : "+v"(pp) :: "memory"); }
            pp += 64 * DM; }
    }
};
struct MoeUnit { int pm, pn, e, mt; };
struct MoeSched {
    int G, c, TT, nN; const LAS int* tstart;
    __device__ __forceinline__ bool next(int i, MoeUnit& u) const {
        pg8::Tile t; if (!pg8::static_tile(i, G, c, TT, nN, t)) return false;
        const int ln = threadIdx.x & 63;
        const int ts = tstart[ln & 31];
        const int e = (int)__builtin_popcountll(__ballot(ln >= 1 && ln < NE && ts <= t.pm));
        u.pm = t.pm; u.pn = t.pn; u.e = e; u.mt = t.pm - tstart[e]; return true; }
};
struct ProbUp {
    typedef MoeUnit Unit;
    MoeSched S; const unsigned char* WT; const int* tokl; const LAS int* cnt; const float* bug; unsigned char* ACT;
    static constexpr bool GATHER = true;
    __device__ __forceinline__ int arow(const Unit&) const { return 0; }
    __device__ __forceinline__ bool next(int i, Unit& u) const { return S.next(i, u); }
    __device__ __forceinline__ void aidx(const Unit& u, const int (&R)[2], int (&tk)[2][2]) const {
        const int n = cnt[u.e]; const GAS int* tl = (const GAS int*)tokl + (size_t)u.e * ECAP + u.mt * 256; const int rmax = n - 1 - u.mt * 256;
#pragma unroll
        for (int h = 0; h < 2; ++h)
#pragma unroll
            for (int i = 0; i < 2; ++i) { int r = h * 128 + R[i]; r = r < rmax ? r : rmax; tk[h][i] = tl[r]; } }
    __device__ __forceinline__ void acalc(const int (&tk)[2][2], const int (&C)[2], unsigned (&o)[2][2]) const {
#pragma unroll
        for (int h = 0; h < 2; ++h)
#pragma unroll
            for (int i = 0; i < 2; ++i) o[h][i] = (unsigned)(tk[h][i] * DM + C[i] * 2); }
    __device__ __forceinline__ const char* bbase(const Unit& u) const { return (const char*)WT + ((size_t)u.e * 2048 + (size_t)u.pn * 256) * DM; }
    __device__ __forceinline__ void epi(const f32x4 (&acc)[2][2][4][2], const Unit& u, int wr, int wc, int fr, int fq) const {
        const int cl = u.pn * 128 + wc * 32 + 8 * fq;
        const float* bg = bug + (size_t)u.e * 2048 + cl;
        const f32x4 bg0 = *(const f32x4*)bg, bg1 = *(const f32x4*)(bg + 4), bu0 = *(const f32x4*)(bg + 1024), bu1 = *(const f32x4*)(bg + 1028);
        typedef _Float16 h2 __attribute__((ext_vector_type(2))); typedef short s2v __attribute__((ext_vector_type(2)));
        h2 bgh[2][2], buh[2][2];
#pragma unroll
        for (int n = 0; n < 2; ++n)
#pragma unroll
            for (int hh = 0; hh < 2; ++hh) { const f32x4 a = n ? bg1 : bg0, b = n ? bu1 : bu0; bgh[n][hh] = __builtin_convertvector((f32x2){a[2 * hh], a[2 * hh + 1]}, h2); buh[n][hh] = __builtin_convertvector((f32x2){b[2 * hh] + 1.f, b[2 * hh + 1] + 1.f}, h2); }
        const h2 k256 = {(_Float16)0.00390625f, (_Float16)0.00390625f}, seven = {(_Float16)7.f, (_Float16)7.f}, msix = {(_Float16)-6.f, (_Float16)-6.f}, eight = {(_Float16)8.f, (_Float16)8.f}, one = {(_Float16)1.f, (_Float16)1.f};
        const h2 cexp = {(_Float16)(-1.702f * LOG2E), (_Float16)(-1.702f * LOG2E)};
        GAS unsigned char* ap = (GAS unsigned char*)ACT + ((size_t)u.pm * 256 + wr * 64 + fr) * DE + cl;
#pragma unroll
        for (int ai = 0; ai < 2; ++ai) {
#pragma unroll
            for (int m = 0; m < 4; ++m) { unsigned w[2];
#pragma unroll
                for (int n = 0; n < 2; ++n) { s2v pk = {0, 0};
#pragma unroll
                    for (int hh = 0; hh < 2; ++hh) {
                        h2 g = __builtin_convertvector((f32x2){acc[ai][0][m][n][2 * hh], acc[ai][0][m][n][2 * hh + 1]}, h2) * k256 + bgh[n][hh];
                        h2 up = __builtin_convertvector((f32x2){acc[ai][1][m][n][2 * hh], acc[ai][1][m][n][2 * hh + 1]}, h2) * k256 + buh[n][hh];
                        g = __builtin_elementwise_min(g, seven); up = __builtin_elementwise_min(__builtin_elementwise_max(up, msix), eight);
                        const h2 t = g * cexp; h2 e; e.x = __builtin_exp2f16(t.x); e.y = __builtin_exp2f16(t.y);
                        const h2 d = e + one; h2 r; r.x = __builtin_amdgcn_rcph(d.x); r.y = __builtin_amdgcn_rcph(d.y);
                        const h2 a = up * (g * r);
                        pk = hh ? __builtin_amdgcn_cvt_scalef32_pk_fp8_f16(pk, a, 1.0f, true) : __builtin_amdgcn_cvt_scalef32_pk_fp8_f16(pk, a, 1.0f, false); }
                    w[n] = __builtin_bit_cast(unsigned, pk); }
                *(GAS u32x2*)ap = (u32x2){w[0], w[1]};
                ap += 16 * DE;
                asm volatile("" : "+v"(ap)); }
            ap += 64 * DE; }
    }
};
struct ProbDown {
    typedef MoeUnit Unit;
    MoeSched S; const unsigned char* WT; const float* gatel; const LAS int* cnt; const float* bd; unsigned char* Y;
    __device__ __forceinline__ bool next(int i, Unit& u) const { return S.next(i, u); }
    static constexpr bool GATHER = false;
    __device__ __forceinline__ int arow(const Unit& u) const { return u.pm * 256; }
    __device__ __forceinline__ void aidx(const Unit&, const int (&)[2], int (&)[2][2]) const {}
    __device__ __forceinline__ void acalc(const int (&)[2][2], const int (&)[2], unsigned (&)[2][2]) const {}
    __device__ __forceinline__ const char* bbase(const Unit& u) const { return (const char*)WT + ((size_t)u.e * 1024 + (size_t)u.pn * 256) * DE; }
    __device__ __forceinline__ void epi(const f32x4 (&acc)[2][2][4][2], const Unit& u, int wr, int wc, int fr, int fq) const {
        const int col0 = u.pn * 256 + wc * 64 + 16 * fq; const int n = cnt[u.e];
        const float* b = bd + (size_t)u.e * DM + col0;
        const f32x4 b00 = *(const f32x4*)b, b01 = *(const f32x4*)(b + 4), b10 = *(const f32x4*)(b + 8), b11 = *(const f32x4*)(b + 12);
        const GAS float* gl = (const GAS float*)gatel + (size_t)u.e * ECAP + u.mt * 256;
        const int rmax = n - 1 - u.mt * 256;
        float gtv[8];
#pragma unroll
        for (int q = 0; q < 8; ++q) { const int r = (q >> 2) * 128 + wr * 64 + (q & 3) * 16 + fr; const float g = gl[r < rmax ? r : rmax]; gtv[q] = (r <= rmax) ? g * 16.f : 0.f; }
        GAS unsigned char* yp = (GAS unsigned char*)Y + ((size_t)u.pm * 256 + wr * 64 + fr) * DM + col0;
#pragma unroll
        for (int ai = 0; ai < 2; ++ai) {
#pragma unroll
            for (int m = 0; m < 4; ++m) { const float gt = gtv[ai * 4 + m]; unsigned w[4];
#pragma unroll
                for (int bj = 0; bj < 2; ++bj) { const f32x4 v0 = (acc[ai][bj][m][0] * 0.00390625f + (bj ? b10 : b00)) * gt, v1 = (acc[ai][bj][m][1] * 0.00390625f + (bj ? b11 : b01)) * gt;
                    w[2 * bj] = pk4_fp8(clamp448(v0[0]), clamp448(v0[1]), clamp448(v0[2]), clamp448(v0[3])); w[2 * bj + 1] = pk4_fp8(clamp448(v1[0]), clamp448(v1[1]), clamp448(v1[2]), clamp448(v1[3])); }
                *(GAS u32x4*)yp = (u32x4){w[0], w[1], w[2], w[3]};
                yp += 16 * DM;
                asm volatile("" : "+v"(yp)); }
            yp += 64 * DM; }
    }
};

__device__ __forceinline__ float log_sigmoid(float z) { return __builtin_fminf(z, 0.f) - log1pf(__expf(-__builtin_fabsf(z))); }
__device__ __forceinline__ int t5_bucket(int n) {
    if (n < 16) return n;
    const float nf = (float)n;
    int large = 16 + (int)(logf(nf / 16.f) / logf(128.f / 16.f) * 16.f);
    return large < 31 ? large : 31;
}

__global__ void __launch_bounds__(NWAVES * 64, 2) hymba_fwd(Args args) {
    extern __shared__ __attribute__((aligned(16))) unsigned char lds_raw[];
    LAS unsigned char* lds = (LAS unsigned char*)lds_raw;
    volatile LAS unsigned* MISC = (volatile LAS unsigned*)(lds + MISC_OFF);
    const int tid = threadIdx.x, lane = tid & 63, wave = __builtin_amdgcn_readfirstlane(tid >> 6);
    const int G = gridDim.x; const int bx = blockIdx.x; const int vcu = (G % 8 == 0) ? (bx % 8) * (G / 8) + bx / 8 : bx;
    unsigned char* ws = args.ws;
    unsigned* ctl = (unsigned*)(ws + WS_CTL);
    bf16_t* WinT = (bf16_t*)(ws + WS_WIN); bf16_t* WoT = (bf16_t*)(ws + WS_WO); bf16_t* KX = (bf16_t*)(ws + WS_KX);
    float* C2F = (float*)(ws + WS_C2F); float* LOGF = (float*)(ws + WS_LOGF);
    int* TOKL = (int*)(ws + WS_TOKL); float* GATEL = (float*)(ws + WS_GATEL); int* SLOT = (int*)(ws + WS_SLOT);
    unsigned char* WugT = ws + WS_WUG; unsigned char* WdT = ws + WS_WD; bf16_t* HN = (bf16_t*)(ws + WS_HN); unsigned char* HN8 = ws + WS_HN;
    bf16_t* QKV = (bf16_t*)(ws + WS_QKV); bf16_t* AO = (bf16_t*)(ws + WS_AO); unsigned char* ACT = ws + WS_ACT; unsigned char* YB = ws + WS_Y; bf16_t* PROJ = (bf16_t*)(ws + WS_PROJ);
    for (int u = tid; u < 256; u += NWAVES * 64) MISC[u] = 0u;
    __syncthreads();
    XcdBarrier bar = xcd_barrier_post(ctl + CW_BAR + args.li * XCD_BAR_WORDS, MISC + 8);
    const int lo = args.ph_lo, hi_ph = args.ph_hi;
#ifndef DUP_MASK
#define DUP_MASK 0
#endif
#define NREP(k) ((((DUP_MASK) >> (k)) & 1) + 1)
#ifdef ONLY_PHASE
#define IN(k) ((k) == ONLY_PHASE && lo <= (k) && (k) < hi_ph)
#else
#define IN(k) (lo <= (k) && (k) < hi_ph)
#endif
#define BOTH(k) (IN(k) && IN((k) + 1))
    const int gw = vcu * NWAVES + wave, NGW = G * NWAVES;

    if (IN(0)) {
      for (int rep = 0; rep < NREP(0); ++rep) {
        LAS float* scr = (LAS float*)(lds + wave * 16384);
        constexpr int I_IN = 16 * (NPROJ / 32), I_O = 16 * 32;
        constexpr int NITEMS = I_IN + I_O;
        for (int it = gw; it < NITEMS; it += NGW) {
            int r = it;
            if (r < I_IN) { const int kb = r / (NPROJ / 32), nb = r % (NPROJ / 32), n0 = nb * 32; transpose_item(args.w_in, DM, INW, kb * 64, n0 + (n0 >= 1536 ? 8 : 0), WinT, n0, scr, lane); continue; } r -= I_IN;
            { const int kb = r / 32, nb = r % 32; transpose_item(args.w_out, DM, DM, kb * 64, nb * 32, WoT, nb * 32, scr, lane); }
        }
        __syncthreads();
        LAS float* wfT = (LAS float*)lds;
        { float tmpw[16];
#pragma unroll
          for (int it = 0; it < 16; ++it) { const int i = tid + it * NWAVES * 64; tmpw[it] = args.w_in[(size_t)(i >> 3) * INW + 1536 + (i & 7)]; }
#pragma unroll
          for (int it = 0; it < 16; ++it) { const int i = tid + it * NWAVES * 64; wfT[(i & 7) * DM + (i >> 3)] = tmpw[it]; } }
        __syncthreads();
        f32x4 gm[4];
#pragma unroll
        for (int j = 0; j < 4; ++j) gm[j] = *(const f32x4*)(args.norm_mix + 4 * lane + 256 * j);
        const float bfl = args.b_forget[lane >> 3];
        f32x4 vn[4], vn2[4];
        { const GAS f32x4* xr = (const GAS f32x4*)(args.x + (size_t)gw * DM) + lane;
#pragma unroll
          for (int j = 0; j < 4; ++j) vn[j] = xr[64 * j];
          const GAS f32x4* xr2 = (const GAS f32x4*)(args.x + (size_t)(gw + NGW < NTOK ? gw + NGW : gw) * DM) + lane;
#pragma unroll
          for (int j = 0; j < 4; ++j) vn2[j] = xr2[64 * j]; }
        for (int m = gw; m < NTOK; m += NGW) {
            f32x4 v[4]; float s = 0.f;
#pragma unroll
            for (int j = 0; j < 4; ++j) { v[j] = vn[j]; vn[j] = vn2[j]; }
            if (m + 2 * NGW < NTOK) { const GAS f32x4* xr = (const GAS f32x4*)(args.x + (size_t)(m + 2 * NGW) * DM) + lane;
#pragma unroll
                for (int j = 0; j < 4; ++j) vn2[j] = xr[64 * j]; }
#pragma unroll
            for (int j = 0; j < 4; ++j) s += (v[j].x * v[j].x + v[j].y * v[j].y) + (v[j].z * v[j].z + v[j].w * v[j].w);
            const float rstd = 1.f / sqrtf(wave_sum(s) * (1.f / DM) + EPS);
            GAS u32x2* o8 = (GAS u32x2*)(HN + (size_t)m * DM) + lane;
            float fl[8];
#pragma unroll
            for (int h = 0; h < 8; ++h) fl[h] = 0.f;
#pragma unroll
            for (int j = 0; j < 4; ++j) { v[j] = v[j] * rstd * gm[j]; o8[64 * j] = (u32x2){cvtpk(v[j].x, v[j].y), cvtpk(v[j].z, v[j].w)};
#pragma unroll
                for (int h = 0; h < 8; ++h) { const f32x4 w = *(const LAS f32x4*)(wfT + h * DM + 4 * lane + 256 * j); float t_ = fl[h];
                    t_ = __builtin_fmaf(v[j].x, w.x, t_); t_ = __builtin_fmaf(v[j].y, w.y, t_); t_ = __builtin_fmaf(v[j].z, w.z, t_); t_ = __builtin_fmaf(v[j].w, w.w, t_); fl[h] = t_; } }
#define DPPF(x, ctrl) __builtin_bit_cast(float, __builtin_amdgcn_update_dpp(0, __builtin_bit_cast(int, (x)), (ctrl), 0xF, 0xF, false))
#pragma unroll
            for (int j = 0; j < 4; ++j) { const auto r_ = __builtin_amdgcn_permlane32_swap(__float_as_uint(fl[j]), __float_as_uint(fl[4 + j]), false, false); fl[j] = __uint_as_float(r_[0]) + __uint_as_float(r_[1]); }
#pragma unroll
            for (int j = 0; j < 2; ++j) { const auto r_ = __builtin_amdgcn_permlane16_swap(__float_as_uint(fl[j]), __float_as_uint(fl[2 + j]), false, false); fl[j] = __uint_as_float(r_[0]) + __uint_as_float(r_[1]); }
            { const bool up = (lane & 8) != 0; const float snd = up ? fl[0] : fl[1]; const float keep = up ? fl[1] : fl[0]; fl[0] = keep + DPPF(snd, 0x128); }
            float z = fl[0]; z += DPPF(z, 0x141); z += DPPF(z, 0x4E); z += DPPF(z, 0xB1);
#undef DPPF
            if ((lane & 7) == 0) { z += bfl;
                const int b = m / SEQ, s_ = m % SEQ; LOGF[(size_t)(b * FH + (lane >> 3)) * SEQ + s_] = log_sigmoid(z); }
        }
        __syncthreads();
      }
        if (BOTH(0)) xcd_barrier(bar);
    }

    if (IN(1)) {
        for (int sq = (G == 256 ? bx - 128 : bx); sq >= 0 && sq < NB * FH; sq += G) {
            LAS double* part = (LAS double*)(lds + AUX_OFF);
            const float* lf = LOGF + (size_t)sq * SEQ + tid * 8;
            const f32x4 a0 = *(const f32x4*)lf, a1 = *(const f32x4*)(lf + 4);
            double v[8] = {a0.x, a0.y, a0.z, a0.w, a1.x, a1.y, a1.z, a1.w};
#pragma unroll
            for (int i = 1; i < 8; ++i) v[i] += v[i - 1];
            double incl = v[7];
#pragma unroll
            for (int o = 1; o < 64; o <<= 1) { const double t = __shfl_up(incl, o); if (lane >= o) incl += t; }
            if (lane == 63) part[wave] = incl;
            __syncthreads();
            double base = incl - v[7];
            for (int w = 0; w < wave; ++w) base += part[w];
            float c2v[8];
#pragma unroll
            for (int i = 0; i < 8; ++i) c2v[i] = (float)((base + v[i]) * (double)LOG2E);
            float* co = C2F + (size_t)sq * SEQ + tid * 8;
            *(f32x4*)co = (f32x4){c2v[0], c2v[1], c2v[2], c2v[3]}; *(f32x4*)(co + 4) = (f32x4){c2v[4], c2v[5], c2v[6], c2v[7]};
            bf16_t* kx = KX + ((size_t)sq * SEQ + tid * 8) * 8;
#pragma unroll
            for (int i = 0; i < 8; ++i) { const float nv = -c2v[i];
                const unsigned h0 = cvtpk(nv, 0.f) & 0xffffu; const float r1 = nv - bf2f((unsigned short)h0);
                const unsigned h1 = cvtpk(r1, 0.f) & 0xffffu; const float r2 = r1 - bf2f((unsigned short)h1);
                const unsigned h2 = cvtpk(r2, 0.f) & 0xffffu;
                *(GAS u32x4*)(kx + i * 8) = (u32x4){h0 | (h1 << 16), h2, 0u, 0u}; }
            __syncthreads();
        }
        ProbIn P{G, bx, WinT, QKV, args.qnf, args.knf, args.qns, args.kns};
        pg8::gemm_phase<2, false, ProbIn>(lds, (const char*)HN, DM * 2, P);
        if (G == 256 && bx >= 128) cv_unit(bx - 128, args.w_ug, args.w_down, WugT, WdT, (LAS float*)lds + wave * 1152, wave, lane);
        if (BOTH(1)) xcd_barrier(bar);
    }

    if (IN(2)) {
        LAS char* shm = (LAS char*)lds;
        { float tbv[4];
#pragma unroll
          for (int it = 0; it < 4; ++it) { const int i = tid + it * NWAVES * 64; const int h = i >> 8, d = (i & 255) - 64; const int dc = d < 0 ? 0 : d > 127 ? 127 : d;
              const float v = args.rel_bias[t5_bucket(dc) * SH + h]; tbv[it] = (d >= 0 && d < 128) ? v * LOG2E : -INFINITY; }
#pragma unroll
          for (int it = 0; it < 4; ++it) ((LAS float*)(shm + att::LDS_TB))[tid + it * NWAVES * 64] = tbv[it]; }
        float gq = 0.f, gk = 0.f, gqs_ = 0.f, gks_ = 0.f;
        { const float* gp = wave == 0 ? args.qnf : wave == 1 ? args.knf : wave == 2 ? args.qns : args.kns;
          float v = (tid < 256) ? __builtin_fabsf(gp[lane]) : 0.f;
#pragma unroll
          for (int o_ = 1; o_ < 64; o_ <<= 1) v = __builtin_fmaxf(v, __shfl_xor(v, o_));
          if (lane == 0) ((volatile LAS float*)MISC)[28 + wave] = v;
          __syncthreads();
          gq = ((volatile LAS float*)MISC)[28]; gk = ((volatile LAS float*)MISC)[29]; gqs_ = ((volatile LAS float*)MISC)[30]; gks_ = ((volatile LAS float*)MISC)[31]; }
        const float thr2 = 150.f + 2.f * (C2 * 64.f * gq * gk * 1.02f) + 1.f;
        float mb = 0.f;
        { float v = (tid < 32 * SH) ? args.rel_bias[tid] : 0.f;
#pragma unroll
          for (int o_ = 1; o_ < 64; o_ <<= 1) v = __builtin_fmaxf(v, __shfl_xor(v, o_));
          if (lane == 0) ((volatile LAS float*)MISC)[24 + wave] = v;
          __syncthreads();
          for (int w = 0; w < 4; ++w) mb = __builtin_fmaxf(mb, ((volatile LAS float*)MISC)[24 + w]); }
        const bool fox_nomax = (C2 * 64.f * gq * gk * 1.02f + 0.5f <= att::THR);
        const bool swa_nomax = (C2 * 64.f * gqs_ * gks_ * 1.02f + mb * LOG2E + 0.5f <= att::THR);
        __syncthreads();
        constexpr int NFOX = NB * FH * (SEQ / 256), NSWA = NB * SKV * (SEQ / 64);
        static_assert((NFOX + NSWA) == 2 * CV_UNITS, "queue interleave: two attention units per conversion unit");
      for (int rep = 0; rep < NREP(2); ++rep)
        for (;;) {
            if (tid == 0) MISC[16] = atomicAdd(ctl + CW_QUEUE + 64 * rep, 1u);
            __syncthreads();
            const int uq = (int)MISC[16];
            int u;
            if (G == 256) {
                if (uq >= 128 * 23) break;
                if (uq < 128 * 15) {
                    const int grp = uq / 15, r = uq % 15;
                    if (r & 1) { cv_unit(128 + grp * 7 + (r >> 1), args.w_ug, args.w_down, WugT, WdT, (LAS float*)(lds + 98304) + wave * 1152, wave, lane); __syncthreads(); continue; }
                    u = grp * 8 + (r >> 1);
                } else u = NFOX + (uq - 128 * 15);
            } else {
                if (uq >= NFOX + NSWA + CV_UNITS) break;
                if (uq % 3 == 2) { cv_unit(uq / 3, args.w_ug, args.w_down, WugT, WdT, (LAS float*)(lds + 98304) + wave * 1152, wave, lane); __syncthreads(); continue; }
                u = (uq / 3) * 2 + uq % 3; }
            att::UnitArgs A;
            if (u < NFOX) {
                const int qb = (SEQ / 256 - 1) - u / (NB * FH), bh = u % (NB * FH), b = bh / FH, h = bh % FH;
                const int q0 = qb * 256;
                const float* c2 = C2F + (size_t)bh * SEQ;
                const float cq0 = c2[q0];
                const int tl = lane;
                const bool keep = (tl <= 4 * qb + 3) && (cq0 - c2[tl * 64 + 63] >= -thr2);
                const unsigned long long mk = __ballot(keep);
                int T0 = mk ? (int)__builtin_ctzll(mk) : 4 * qb; if (T0 > 4 * qb) T0 = 4 * qb; T0 = __builtin_amdgcn_readfirstlane(T0);
                const float cqw = c2[q0 + wave * 32];
                const unsigned long long mkw = __ballot((tl <= 4 * qb + 3) && (cqw - c2[tl * 64 + 63] >= -thr2));
                int T0w = mkw ? (int)__builtin_ctzll(mkw) : T0; if (T0w < T0) T0w = T0; if (T0w > 4 * qb) T0w = 4 * qb; T0w = __builtin_amdgcn_readfirstlane(T0w);
                const size_t rowb = (size_t)b * SEQ;
                A.Qw = QKV + (rowb + q0 + wave * 32) * QKVP + COL_FQ + h * HD;
                A.Kh = QKV + (rowb + T0 * 64) * QKVP + COL_FK + h * HD;
                A.Vh = QKV + (rowb + T0 * 64) * QKVP + COL_FV + h * HD;
                A.kx = KX + ((size_t)bh * SEQ + T0 * 64) * 8;
                A.Ow = AO + (rowb + q0 + wave * 32) * DM + h * HD;
                A.nt = 4 * qb + 4 - T0; A.nomax = fox_nomax; A.t_first = T0w - T0; A.qw_rel = q0 + wave * 32 - T0 * 64; A.tb_off = 0; A.sink2 = __builtin_bit_cast(float, __builtin_amdgcn_readfirstlane(__builtin_bit_cast(int, cqw)));
                att::attn_unit<true>(A, shm);
            } else {
                const int v = u - NFOX, blk = v % (SEQ / 64), bk = v / (SEQ / 64), kvh = bk % SKV, b = bk / SKV;
                const int q0 = blk * 64, T0 = blk >= 2 ? blk - 2 : 0, hq = kvh * 4 + (wave >> 1), qw = q0 + (wave & 1) * 32;
                const size_t rowb = (size_t)b * SEQ;
                A.Qw = QKV + (rowb + qw) * QKVP + COL_SQ + hq * HD;
                A.Kh = QKV + (rowb + T0 * 64) * QKVP + COL_SK + kvh * HD;
                A.Vh = QKV + (rowb + T0 * 64) * QKVP + COL_SV + kvh * HD;
                A.kx = nullptr;
                A.Ow = AO + (rowb + qw) * DM + 512 + hq * HD;
                A.nt = blk + 1 - T0; A.nomax = swa_nomax; A.t_first = 0; A.qw_rel = qw - T0 * 64; A.tb_off = att::LDS_TB + hq * 1024; A.sink2 = args.sinks[hq] * LOG2E;
                att::attn_unit<false>(A, shm);
            }
        }
        if (BOTH(2)) xcd_barrier(bar);
    }

    if (IN(3)) {
        ProbOut P{G, bx, WoT, PROJ};
        pg8::gemm_phase<1, false, ProbOut>(lds, (const char*)AO, DM * 2, P);
        if (BOTH(3)) xcd_barrier(bar);
    }

    if (IN(4)) {
        LAS float* wrT = (LAS float*)lds;
        for (int kk = 0; kk < 2; ++kk) { const int k = tid + 512 * kk;
            f32x4 r[8];
#pragma unroll
            for (int q = 0; q < 8; ++q) r[q] = *(const f32x4*)(args.w_router + (size_t)k * NE + 4 * q);
#pragma unroll
            for (int q = 0; q < 8; ++q)
#pragma unroll
                for (int c = 0; c < 4; ++c) wrT[(4 * q + c) * DM + k] = r[q][c]; }
        LAS float* lg = (LAS float*)(lds + AUX_OFF) + wave * 512;
        LAS int* tokE = (LAS int*)(lds + TOKS_OFF);
        LAS float* tokG = (LAS float*)(lds + TOKS_OFF + 2048);
        LAS int* hist = (LAS int*)(lds + MISC_OFF + 128);
        LAS int* hbase = (LAS int*)(lds + MISC_OFF + 256);
        LAS int* hrun = (LAS int*)(lds + MISC_OFF + 384);
        f32x4 gm[4];
#pragma unroll
        for (int j = 0; j < 4; ++j) gm[j] = *(const f32x4*)(args.norm_moe + 4 * lane + 256 * j);
        float brl[4];
#pragma unroll
        for (int ec = 0; ec < 4; ++ec) brl[ec] = args.b_router[ec * 8 + (lane >> 3)];
        __syncthreads();
        for (int chunk = vcu; chunk < NTOK / 128; chunk += G) {
            if (tid < 32) { hist[tid] = 0; hrun[tid] = 0; }
            __syncthreads();
            const int tok0 = chunk * 128 + wave * 16;
#pragma unroll 1
            for (int it = 0; it < 4; ++it) {
                f32x4 v[4][4];
                { u32x2 pn_[4][4];
#pragma unroll
                  for (int tt = 0; tt < 4; ++tt) { const size_t ro = (size_t)(tok0 + 4 * it + tt) * DM;
                      const GAS f32x4* xr = (const GAS f32x4*)(args.x + ro) + lane; const GAS u32x2* pr = (const GAS u32x2*)(PROJ + ro) + lane;
#pragma unroll
                      for (int j = 0; j < 4; ++j) { v[tt][j] = xr[64 * j]; pn_[tt][j] = pr[64 * j]; } }
#pragma unroll
                  for (int tt = 0; tt < 4; ++tt)
#pragma unroll
                      for (int j = 0; j < 4; ++j) { const u32x2 p = pn_[tt][j]; v[tt][j] += (f32x4){__builtin_bit_cast(float, p.x << 16), __builtin_bit_cast(float, p.x & 0xffff0000u), __builtin_bit_cast(float, p.y << 16), __builtin_bit_cast(float, p.y & 0xffff0000u)}; } }
#pragma unroll
                for (int tt = 0; tt < 4; ++tt) { GAS u32x2* hw = (GAS u32x2*)(PROJ + (size_t)(tok0 + 4 * it + tt) * DM) + lane;
#pragma unroll
                    for (int j = 0; j < 4; ++j) hw[64 * j] = (u32x2){cvtpk(v[tt][j].x, v[tt][j].y), cvtpk(v[tt][j].z, v[tt][j].w)}; }
#pragma unroll
                for (int tt = 0; tt < 4; ++tt) { float s = 0.f;
#pragma unroll
                    for (int j = 0; j < 4; ++j) s += (v[tt][j].x * v[tt][j].x + v[tt][j].y * v[tt][j].y) + (v[tt][j].z * v[tt][j].z + v[tt][j].w * v[tt][j].w);
                    const float rs = 1.f / sqrtf(wave_sum(s) * (1.f / DM) + EPS);
                    GAS unsigned* o4 = (GAS unsigned*)(HN8 + (size_t)(tok0 + 4 * it + tt) * DM) + lane;
#pragma unroll
                    for (int j = 0; j < 4; ++j) { v[tt][j] = v[tt][j] * rs * gm[j]; o4[64 * j] = pk4_fp8(v[tt][j].x, v[tt][j].y, v[tt][j].z, v[tt][j].w); } }
#pragma unroll 1
                for (int ec = 0; ec < 4; ++ec) {
                    const float brl_ec = ec == 0 ? brl[0] : ec == 1 ? brl[1] : ec == 2 ? brl[2] : brl[3];
                    float a[4][8];
#pragma unroll
                    for (int e = 0; e < 8; ++e) {
#pragma unroll
                        for (int tt = 0; tt < 4; ++tt) a[tt][e] = 0.f;
#pragma unroll
                        for (int j = 0; j < 4; ++j) { const f32x4 w = *(const LAS f32x4*)(wrT + (ec * 8 + e) * DM + 4 * lane + 256 * j);
#pragma unroll
                            for (int tt = 0; tt < 4; ++tt) { float t_ = a[tt][e];
                                t_ = __builtin_fmaf(v[tt][j].x, w.x, t_); t_ = __builtin_fmaf(v[tt][j].y, w.y, t_); t_ = __builtin_fmaf(v[tt][j].z, w.z, t_); t_ = __builtin_fmaf(v[tt][j].w, w.w, t_); a[tt][e] = t_; } }
                        if (e & 1) asm volatile("" ::: "memory"); }
#define RS_SW32(P, N) _Pragma("unroll") for (int j = 0; j < (N); ++j) { const auto r_ = __builtin_amdgcn_permlane32_swap(__float_as_uint(P[j]), __float_as_uint(P[(N) + j]), false, false); P[j] = __uint_as_float(r_[0]) + __uint_as_float(r_[1]); }
#define RS_SW16(P, N) _Pragma("unroll") for (int j = 0; j < (N); ++j) { const auto r_ = __builtin_amdgcn_permlane16_swap(__float_as_uint(P[j]), __float_as_uint(P[(N) + j]), false, false); P[j] = __uint_as_float(r_[0]) + __uint_as_float(r_[1]); }
#define DPPF(x, ctrl) __builtin_bit_cast(float, __builtin_amdgcn_update_dpp(0, __builtin_bit_cast(int, (x)), (ctrl), 0xF, 0xF, false))
#pragma unroll
                    for (int tt = 0; tt < 4; ++tt) { RS_SW32(a[tt], 4) RS_SW16(a[tt], 2)
                        { const bool up = (lane & 8) != 0; const float snd = up ? a[tt][0] : a[tt][1]; const float keep = up ? a[tt][1] : a[tt][0]; a[tt][0] = keep + DPPF(snd, 0x128); }
                        float sfull = a[tt][0]; sfull += DPPF(sfull, 0x141); sfull += DPPF(sfull, 0x4E); sfull += DPPF(sfull, 0xB1);
                        if ((lane & 7) == 0) { const int e = ec * 8 + (lane >> 3); lg[(4 * it + tt) * 32 + e] = sfull + brl_ec; } }
#undef RS_SW32
#undef RS_SW16
#undef DPPF
                }
            }
            LDS_WAIT();
            int tidl = tid; asm volatile("" : "+v"(tidl));
            const int lanel = tidl & 63;
            if (lanel < 16) {
                float l[32];
#pragma unroll
                for (int e = 0; e < 32; ++e) l[e] = lg[lanel * 32 + e];
                int ei[4]; float ev[4];
#pragma unroll
                for (int k = 0; k < 4; ++k) { float bv = -INFINITY; int bi = 0;
#pragma unroll
                    for (int e = 0; e < 32; ++e) { const bool gt = l[e] > bv; bv = gt ? l[e] : bv; bi = gt ? e : bi; }
                    ei[k] = bi; ev[k] = bv;
#pragma unroll
                    for (int e = 0; e < 32; ++e) l[e] = (e == bi) ? -INFINITY : l[e]; }
                float ex[4], sum = 0.f;
#pragma unroll
                for (int k = 0; k < 4; ++k) { ex[k] = __expf(ev[k] - ev[0]); sum += ex[k]; }
                const float inv = 1.f / sum; const int tl = wave * 16 + lanel;
#pragma unroll
                for (int k = 0; k < 4; ++k) { tokE[tl * 4 + k] = ei[k]; tokG[tl * 4 + k] = ex[k] * inv; __hip_atomic_fetch_add(hist + ei[k], 1, __ATOMIC_RELAXED, __HIP_MEMORY_SCOPE_WORKGROUP); }
            }
            __syncthreads();
            if (tidl < 32) hbase[tidl] = (int)atomicAdd(ctl + CW_CNT + 64 * tidl, (unsigned)hist[tidl]);
            __syncthreads();
            { const int tl = tidl >> 2, k = tidl & 3, e = tokE[tidl]; const int pos = hbase[e] + __hip_atomic_fetch_add(hrun + e, 1, __ATOMIC_RELAXED, __HIP_MEMORY_SCOPE_WORKGROUP);
              const int tok = chunk * 128 + tl;
              TOKL[(size_t)e * ECAP + pos] = tok; GATEL[(size_t)e * ECAP + pos] = tokG[tidl]; SLOT[tok * 4 + k] = e * ECAP + pos; }
            __syncthreads();
        }
        if (BOTH(4)) xcd_barrier(bar);
    }

    LAS int* ecnt = (LAS int*)(lds + MISC_OFF + 512);
    LAS int* tstart = (LAS int*)(lds + MISC_OFF + 640);
    if (IN(5) || IN(6) || IN(7)) {
        if (tid < 64) {
            const int e = lane & 31;
            const int n = (int)__hip_atomic_load(ctl + CW_CNT + 64 * e, __ATOMIC_RELAXED, __HIP_MEMORY_SCOPE_AGENT);
            int incl = (n + 255) >> 8;
#pragma unroll
            for (int o = 1; o < 32; o <<= 1) { const int t = __shfl_up(incl, o, 32); if (e >= o) incl += t; }
            if (lane < 32) { ecnt[e] = n; tstart[e] = incl - ((n + 255) >> 8); if (e == 31) tstart[NE] = incl; } }
        __syncthreads();
    }
    if (IN(5)) {
        MoeSched S{G, bx, tstart[NE], 8, tstart};
        ProbUp P{S, WugT, TOKL, ecnt, args.b_ug, ACT};
        for (int rep = 0; rep < NREP(5); ++rep) pg8::gemm_phase<1, true, ProbUp>(lds, (const char*)HN8, DM, P);
        if (BOTH(5)) xcd_barrier(bar);
    }
    if (IN(6)) {
        MoeSched S{G, bx, tstart[NE], 4, tstart};
        ProbDown P{S, WdT, GATEL, ecnt, args.b_down, YB};
        for (int rep = 0; rep < NREP(6); ++rep) pg8::gemm_phase<3, true, ProbDown>(lds, (const char*)ACT, DE, P);
        if (BOTH(6)) xcd_barrier(bar);
    }

    if (IN(7)) {
        for (int b0 = gw * 16; b0 < NTOK; b0 += NGW * 16) {
            const int sl = SLOT[b0 * 4 + lane]; const int se = sl / ECAP; const int rowv = tstart[se] * 256 + (sl - se * ECAP);
            f32x4 xa[4], xb[4]; u32x2 pa[4], pb[4]; unsigned ya[4][4], yb[4][4];
#define P7_LOAD(X, P, Y, t) do { const size_t ro = (size_t)(b0 + (t)) * DM; const GAS u32x2* pr = (const GAS u32x2*)(PROJ + ro) + lane; \
                _Pragma("unroll") for (int k = 0; k < 4; ++k) { const size_t yr = (size_t)__builtin_amdgcn_readlane(rowv, 4 * (t) + k) * DM; \
                    _Pragma("unroll") for (int j = 0; j < 4; ++j) Y[k][j] = *((const GAS unsigned*)(YB + yr) + lane + 64 * j); } \
                _Pragma("unroll") for (int j = 0; j < 4; ++j) { P[j] = pr[64 * j]; } } while (0)
#define P7_COMP(X, P, Y, t) do { GAS f32x4* orow = (GAS f32x4*)(args.out + (size_t)(b0 + (t)) * DM) + lane; \
                _Pragma("unroll") for (int j = 0; j < 4; ++j) { f32x4 sacc = {0.f, 0.f, 0.f, 0.f}; \
                    _Pragma("unroll") for (int k = 0; k < 4; ++k) { const f32x2 lo2 = __builtin_amdgcn_cvt_pk_f32_fp8((int)Y[k][j], false), hi2 = __builtin_amdgcn_cvt_pk_f32_fp8((int)Y[k][j], true); \
                        sacc.x += lo2.x; sacc.y += lo2.y; sacc.z += hi2.x; sacc.w += hi2.y; } \
                    const f32x4 pf = {__builtin_bit_cast(float, P[j].x << 16), __builtin_bit_cast(float, P[j].x & 0xffff0000u), __builtin_bit_cast(float, P[j].y << 16), __builtin_bit_cast(float, P[j].y & 0xffff0000u)}; \
                    orow[64 * j] = pf + sacc * (1.f / 16.f); } } while (0)
            P7_LOAD(xa, pa, ya, 0);
#pragma unroll 1
            for (int t = 0; t < 16; t += 2) {
                P7_LOAD(xb, pb, yb, t + 1);
                P7_COMP(xa, pa, ya, t);
                if (t + 2 < 16) P7_LOAD(xa, pa, ya, t + 2);
                P7_COMP(xb, pb, yb, t + 1);
            }
#undef P7_LOAD
#undef P7_COMP
        }
    }
#undef IN
#undef BOTH
}

#ifndef N_LAUNCH_CUTS
#define N_LAUNCH_CUTS 1
#endif
extern "C" void kernel_launch(void* const* d_in, const int* in_sizes, int n_in, void* d_out, int out_size, void* d_ws, size_t ws_size, hipStream_t stream) {
    static int grid = 0;
    if (grid == 0) {
        if (n_in != 18 || out_size != NTOK * DM || ws_size < WS_END) { fprintf(stderr, "kernel_launch: unexpected shapes (n_in %d out %d ws %zu)\n", n_in, out_size, ws_size); grid = -1; return; }
        int dev = 0, cus = 0, per_cu = 0;
        if (hipGetDevice(&dev) != hipSuccess || hipDeviceGetAttribute(&cus, hipDeviceAttributeMultiprocessorCount, dev) != hipSuccess) { grid = -1; return; }
        if (hipFuncSetAttribute((const void*)hymba_fwd, hipFuncAttributeMaxDynamicSharedMemorySize, LDS_BYTES) != hipSuccess) { fprintf(stderr, "kernel_launch: hipFuncSetAttribute failed\n"); grid = -1; return; }
        if (hipOccupancyMaxActiveBlocksPerMultiprocessor(&per_cu, (const void*)hymba_fwd, NWAVES * 64, LDS_BYTES) != hipSuccess || per_cu < 1) { fprintf(stderr, "kernel_launch: occupancy query says %d\n", per_cu); }
        (void)hipGetLastError();
        grid = cus;
    }
    if (grid < 0) return;
    (void)hipMemsetAsync((char*)d_ws + WS_CTL, 0, CTL_ZERO_BYTES, stream);
    Args a{};
    a.x = (const float*)d_in[0]; a.norm_mix = (const float*)d_in[1]; a.w_in = (const float*)d_in[2]; a.b_forget = (const float*)d_in[3];
    a.qnf = (const float*)d_in[4]; a.knf = (const float*)d_in[5]; a.qns = (const float*)d_in[6]; a.kns = (const float*)d_in[7];
    a.sinks = (const float*)d_in[8]; a.rel_bias = (const float*)d_in[9]; a.w_out = (const float*)d_in[10]; a.norm_moe = (const float*)d_in[11];
    a.w_router = (const float*)d_in[12]; a.b_router = (const float*)d_in[13]; a.w_ug = (const float*)d_in[14]; a.b_ug = (const float*)d_in[15];
    a.w_down = (const float*)d_in[16]; a.b_down = (const float*)d_in[17]; a.out = (float*)d_out; a.ws = (unsigned char*)d_ws;
    constexpr int NPH = 8;
    if (N_LAUNCH_CUTS == 1) { a.ph_lo = 0; a.ph_hi = NPH; a.li = 0; hipLaunchKernelGGL(hymba_fwd, dim3(grid), dim3(NWAVES * 64), LDS_BYTES, stream, a); }
    else for (int p = 0; p < NPH; ++p) { a.ph_lo = p; a.ph_hi = p + 1; a.li = 0; hipLaunchKernelGGL(hymba_fwd, dim3(grid), dim3(NWAVES * 64), LDS_BYTES, stream, a); }
}
```
